# Optimizing an MI355X kernel written in HIP

```python
import math
import jax, jax.numpy as jnp
from jax import lax
import numpy as np

D_MODEL = 1024
BATCH = 2
SEQ = 16384
DEPTH = 2

GRID_W = 64
CTX_LEN = 256

NA_HEADS = 8
NA_HEAD_DIM = 64
NA_DIM = NA_HEADS * NA_HEAD_DIM
NA_WIN_ROWS = 8
NA_WIN_COLS = 16
GM_GROUPS = 4
GM_GROUP_DIM = 128
GM_WIDTH = GM_GROUPS * GM_GROUP_DIM
GM_CHUNK = 128
AB_QKV = 3 * NA_DIM
AB_IN = AB_QKV + 2 * GM_WIDTH
AB_MIX = NA_DIM + GM_WIDTH
HY_WIDTH = D_MODEL
HY_SHORT = 3
HY_BANDS = 16
HY_EMB = 1 + 2 * HY_BANDS
HY_FFN = 64
HY_DECAY_TARGET = 1e-2
HY_FAST_PCT = 0.3
HY_SLOW_PCT = 1.5
PEER_HEADS = 8
PEER_NKEYS = 128
PEER_EXPERTS = PEER_NKEYS * PEER_NKEYS
PEER_DK = 256
PEER_TOPK = 16
PEER_BLOCK = 128

N_AB = (DEPTH + 1) // 2
N_C = DEPTH // 2
DN_ALPHA = (2 * DEPTH) ** 0.25
DN_BETA = (8 * DEPTH) ** -0.25
LN_EPS = 1e-5
F32 = jnp.float32

kernel_name = 'hybrid_natten_gmlp_hyena_peer_dit'


def normalize(x):
    xf = x.astype(F32)
    mu = jnp.mean(xf, axis=-1, keepdims=True)
    var = jnp.mean(jnp.square(xf - mu), axis=-1, keepdims=True)
    return ((xf - mu) * lax.rsqrt(var + LN_EPS)).astype(x.dtype)


def layer_norm(x, g, b):
    return normalize(x) * g + b


def modulate(x, shift, scale):
    return x * (1 + scale) + shift


def split_heads(t):
    return t.reshape(t.shape[0], t.shape[1], NA_HEADS, NA_HEAD_DIM)


def neighbourhood_attention(q, k, v, k_ctx, v_ctx, rpb):
    B, L, H, dh = q.shape
    rows = L // GRID_W
    wr = min(NA_WIN_ROWS, rows)
    wc = NA_WIN_COLS
    qg = q.reshape(B, rows, GRID_W, H, dh)
    kg = k.reshape(B, rows, GRID_W, H, dh)
    vg = v.reshape(B, rows, GRID_W, H, dh)
    cols = jnp.arange(GRID_W)
    col_start = jnp.clip(cols - wc // 2, 0, GRID_W - wc)
    col_idx = col_start[:, None] + jnp.arange(wc)[None, :]
    col_rel = col_idx - cols[:, None] + (NA_WIN_COLS - 1)
    scale = dh ** -0.5

    def row_block(r):
        rs = jnp.clip(r - wr // 2, 0, rows - wr)
        q_r = lax.dynamic_index_in_dim(qg, r, axis=1, keepdims=False)
        k_r = lax.dynamic_slice_in_dim(kg, rs, wr, axis=1)[:, :, col_idx]
        v_r = lax.dynamic_slice_in_dim(vg, rs, wr, axis=1)[:, :, col_idx]
        row_rel = rs + jnp.arange(wr) - r + (NA_WIN_ROWS - 1)
        bias = rpb[:, row_rel][:, :, col_rel].transpose(0, 2, 1, 3)
        s_loc = jnp.einsum('bqhd,brqwhd->bhqrw', q_r, k_r).astype(F32) * scale + bias[None].astype(F32)
        s_ctx = jnp.einsum('bqhd,bkhd->bhqk', q_r, k_ctx).astype(F32) * scale
        logits = jnp.concatenate([s_loc.reshape(B, H, GRID_W, wr * wc), s_ctx], axis=-1)
        p = jax.nn.softmax(logits, axis=-1).astype(v.dtype)
        p_loc = p[..., :wr * wc].reshape(B, H, GRID_W, wr, wc)
        p_ctx = p[..., wr * wc:]
        return (jnp.einsum('bhqrw,brqwhd->bqhd', p_loc, v_r)
                + jnp.einsum('bhqk,bkhd->bqhd', p_ctx, v_ctx))

    out = lax.map(row_block, jnp.arange(rows))
    return out.transpose(1, 0, 2, 3, 4).reshape(B, L, H * dh)


def context_attention(q, k, v):
    B, Lc, H, dh = q.shape
    s = jnp.einsum('bqhd,bkhd->bhqk', q, k).astype(F32) * dh ** -0.5
    p = jax.nn.softmax(s, axis=-1).astype(v.dtype)
    return jnp.einsum('bhqk,bkhd->bqhd', p, v).reshape(B, Lc, H * dh)


def chunk_spatial_gating(u, gv, w_s, b_s):
    B, L, _ = u.shape
    n = L // GM_CHUNK
    gvc = normalize(gv).reshape(B, n, GM_CHUNK, GM_GROUPS, GM_GROUP_DIM)
    mixed = jnp.einsum('gpq,bnqgc->bnpgc', w_s, gvc) + b_s.T[None, None, :, :, None]
    return u * mixed.reshape(B, L, GM_WIDTH)


def ab_project(h, w_in):
    p = h @ w_in
    q, k, v = [split_heads(t) for t in jnp.split(p[..., :AB_QKV], 3, axis=-1)]
    u, gv = jnp.split(jax.nn.gelu(p[..., AB_QKV:], approximate=False), 2, axis=-1)
    return q, k, v, u, gv


def mixer_ab(h, h_ctx, w_in, w_out, rpb, w_s, b_s, ctx_out):
    q, k, v, u, gv = ab_project(h, w_in)
    if ctx_out:
        qc, kc, vc, uc, gvc = ab_project(h_ctx, w_in)
    else:
        kc, vc = [split_heads(t) for t in jnp.split(h_ctx @ w_in[:, NA_DIM:AB_QKV], 2, axis=-1)]
    a = neighbourhood_attention(q, k, v, kc, vc, rpb)
    g = chunk_spatial_gating(u, gv, w_s, b_s)
    y = jnp.concatenate([a, g], axis=-1) @ w_out
    y_ctx = None
    if ctx_out:
        ac = context_attention(qc, kc, vc)
        gc = chunk_spatial_gating(uc, gvc, w_s, b_s)
        y_ctx = jnp.concatenate([ac, gc], axis=-1) @ w_out
    return y, y_ctx


def hyena_filter(L, w1, b1, f1, w2, b2, f2, w3):
    w1, b1, f1, w2, b2, f2, w3 = [t.astype(F32) for t in (w1, b1, f1, w2, b2, f2, w3)]
    t = jnp.linspace(0.0, 1.0, L, dtype=F32)[:, None]
    ang = 2.0 * math.pi * jnp.arange(L, dtype=F32)[:, None] / L
    bands = jnp.linspace(1e-4, HY_BANDS - 1, HY_BANDS, dtype=F32)[None, :]
    z = jnp.concatenate([t, jnp.cos(bands * ang), jnp.sin(-bands * ang)], axis=-1)
    hid = jnp.sin(f1 * (z @ w1 + b1))
    hid = jnp.sin(f2 * (hid @ w2 + b2))
    filt = hid @ w3
    deltas = jnp.abs(jnp.linspace(math.log(HY_DECAY_TARGET) / HY_SLOW_PCT,
                                  math.log(HY_DECAY_TARGET) / HY_FAST_PCT, HY_WIDTH, dtype=F32))
    decay = jnp.exp(-t * deltas[None, :])
    fwd = filt[:, :HY_WIDTH] * decay
    bwd = filt[:, HY_WIDTH:] * decay
    l1 = jnp.sum(jnp.abs(fwd), axis=0) + jnp.sum(jnp.abs(bwd[1:]), axis=0)
    k2 = jnp.concatenate([fwd, jnp.zeros((1, HY_WIDTH), F32), bwd[:0:-1]], axis=0)
    return k2 / l1[None, :]


def long_conv(v, k2):
    L = v.shape[1]
    vf = jnp.fft.rfft(v.astype(F32), n=2 * L, axis=1)
    kf = jnp.fft.rfft(k2, n=2 * L, axis=0)
    y = jnp.fft.irfft(vf * kf[None], n=2 * L, axis=1)[:, :L]
    return y.astype(v.dtype)


def hyena(h, w_in, b_in, conv_w, conv_b, w1, b1, f1, w2, b2, f2, w3, d_skip, w_out):
    L = h.shape[1]
    z = h @ w_in + b_in
    z = lax.conv_general_dilated(z, conv_w[:, None, :], window_strides=(1,), padding=[(1, 1)],
                                 dimension_numbers=('NWC', 'WIO', 'NWC'),
                                 feature_group_count=3 * HY_WIDTH) + conv_b
    x0, x1, v = jnp.split(z, 3, axis=-1)
    k2 = hyena_filter(L, w1, b1, f1, w2, b2, f2, w3)
    v = v * x1
    y = (long_conv(v, k2) + v * d_skip) * x0
    return y @ w_out


def peer(h, wq, keys, u_tab, v_tab):
    B, L, D = h.shape
    n_tok = B * L
    xt = h.reshape(n_tok, D)
    q = (xt @ wq).reshape(n_tok, PEER_HEADS, 2, PEER_DK // 2)
    s = jnp.einsum('nhpd,hpkd->nhpk', q, keys).astype(F32)
    s1, i1 = lax.top_k(s[:, :, 0], PEER_TOPK)
    s2, i2 = lax.top_k(s[:, :, 1], PEER_TOPK)
    cand_s = (s1[..., :, None] + s2[..., None, :]).reshape(n_tok, PEER_HEADS, PEER_TOPK * PEER_TOPK)
    cand_i = (i1[..., :, None] * PEER_NKEYS + i2[..., None, :]).reshape(n_tok, PEER_HEADS, PEER_TOPK * PEER_TOPK)
    top_s, pos = lax.top_k(cand_s, PEER_TOPK)
    idx = jnp.take_along_axis(cand_i, pos, axis=-1)
    gate = jax.nn.softmax(top_s, axis=-1)
    nblk = n_tok // PEER_BLOCK

    def block(args):
        xb, ib, gb = args
        act = jax.nn.gelu(jnp.einsum('nd,nhkd->nhk', xb, u_tab[ib]).astype(F32), approximate=False)
        w = (gb * act).astype(xb.dtype)
        return jnp.einsum('nhk,nhkd->nd', w, v_tab[ib])

    out = lax.map(block, (xt.reshape(nblk, PEER_BLOCK, D),
                          idx.reshape(nblk, PEER_BLOCK, PEER_HEADS, PEER_TOPK),
                          gate.reshape(nblk, PEER_BLOCK, PEER_HEADS, PEER_TOPK)))
    return out.reshape(B, L, D)


def setup_inputs(seed: int = 0) -> dict:
    key = jax.random.key(seed)
    ks = iter(jax.random.split(key, 40))
    D = D_MODEL

    def nrm(shape, s):
        return jax.random.normal(next(ks), shape, F32) * s

    return {
        'x': nrm((BATCH, SEQ, D), 1.0),
        'c': nrm((BATCH, D), 1.0),
        'ctx': nrm((BATCH, CTX_LEN, D), 1.0),
        'c_ctx': nrm((D,), 1.0),
        'mod_w': nrm((DEPTH, D, 6 * D), D ** -0.5),
        'mod_b': nrm((DEPTH, 6 * D), 0.02),
        'ln_g': 1.0 + nrm((DEPTH, 2, D), 0.02),
        'ln_b': nrm((DEPTH, 2, D), 0.02),
        'ab_w_in': nrm((N_AB, D, AB_IN), D ** -0.5),
        'ab_w_out': nrm((N_AB, AB_MIX, D), DN_BETA * AB_MIX ** -0.5),
        'na_rpb': nrm((N_AB, NA_HEADS, 2 * NA_WIN_ROWS - 1, 2 * NA_WIN_COLS - 1), 0.5),
        'gm_w_s': nrm((N_AB, GM_GROUPS, GM_CHUNK, GM_CHUNK), GM_CHUNK ** -0.5),
        'gm_b_s': 1.0 + nrm((N_AB, GM_GROUPS, GM_CHUNK), 0.02),
        'hy_w_in': nrm((N_C, D, 3 * HY_WIDTH), D ** -0.5),
        'hy_b_in': nrm((N_C, 3 * HY_WIDTH), 0.02),
        'hy_conv_w': nrm((N_C, HY_SHORT, 3 * HY_WIDTH), HY_SHORT ** -0.5),
        'hy_conv_b': nrm((N_C, 3 * HY_WIDTH), 0.02),
        'hy_ffn_w1': nrm((N_C, HY_EMB, HY_FFN), HY_EMB ** -0.5),
        'hy_ffn_b1': nrm((N_C, HY_FFN), 0.02),
        'hy_ffn_f1': 1.0 + nrm((N_C, HY_FFN), 0.02),
        'hy_ffn_w2': nrm((N_C, HY_FFN, HY_FFN), HY_FFN ** -0.5),
        'hy_ffn_b2': nrm((N_C, HY_FFN), 0.02),
        'hy_ffn_f2': 1.0 + nrm((N_C, HY_FFN), 0.02),
        'hy_ffn_w3': nrm((N_C, HY_FFN, 2 * HY_WIDTH), HY_FFN ** -0.5),
        'hy_d': nrm((N_C, HY_WIDTH), 0.5),
        'hy_w_out': nrm((N_C, HY_WIDTH, D), DN_BETA * HY_WIDTH ** -0.5),
        'peer_wq': nrm((DEPTH, D, PEER_HEADS * PEER_DK), D ** -0.5),
        'peer_keys': nrm((DEPTH, PEER_HEADS, 2, PEER_NKEYS, PEER_DK // 2), (PEER_DK // 2) ** -0.5),
        'peer_u': nrm((DEPTH, PEER_EXPERTS, D), D ** -0.5),
        'peer_v': nrm((DEPTH, PEER_EXPERTS, D), DN_BETA),
    }


def reference(x, c, ctx, c_ctx, mod_w, mod_b, ln_g, ln_b, ab_w_in, ab_w_out, na_rpb, gm_w_s, gm_b_s,
              hy_w_in, hy_b_in, hy_conv_w, hy_conv_b, hy_ffn_w1, hy_ffn_b1, hy_ffn_f1, hy_ffn_w2,
              hy_ffn_b2, hy_ffn_f2, hy_ffn_w3, hy_d, hy_w_out, peer_wq, peer_keys, peer_u, peer_v):
    D = D_MODEL
    for i in range(DEPTH):
        j = i // 2
        ctx_out = any(m % 2 == 0 for m in range(i + 1, DEPTH))
        mod = (jax.nn.silu(c) @ mod_w[i] + mod_b[i])[:, None, :]
        sh1, sc1, g1, sh2, sc2, g2 = jnp.split(mod, 6, axis=-1)
        h = modulate(x, sh1, sc1)
        if i % 2 == 0 or ctx_out:
            mod_c = (jax.nn.silu(c_ctx[None, :]) @ mod_w[i] + mod_b[i])[:, None, :]
            csh1, csc1, cg1, csh2, csc2, cg2 = jnp.split(mod_c, 6, axis=-1)
            h_ctx = modulate(ctx, csh1, csc1)
        if i % 2 == 0:
            y, y_ctx = mixer_ab(h, h_ctx, ab_w_in[j], ab_w_out[j], na_rpb[j], gm_w_s[j], gm_b_s[j], ctx_out)
        else:
            hy_args = (hy_w_in[j], hy_b_in[j], hy_conv_w[j], hy_conv_b[j], hy_ffn_w1[j], hy_ffn_b1[j],
                       hy_ffn_f1[j], hy_ffn_w2[j], hy_ffn_b2[j], hy_ffn_f2[j], hy_ffn_w3[j], hy_d[j], hy_w_out[j])
            y = hyena(h, *hy_args)
            y_ctx = hyena(h_ctx, *hy_args) if ctx_out else None
        x = layer_norm(DN_ALPHA * x + g1 * y, ln_g[i, 0], ln_b[i, 0])
        x = layer_norm(DN_ALPHA * x + g2 * peer(modulate(x, sh2, sc2), peer_wq[i], peer_keys[i], peer_u[i], peer_v[i]),
                       ln_g[i, 1], ln_b[i, 1])
        if ctx_out:
            ctx = layer_norm(DN_ALPHA * ctx + cg1 * y_ctx, ln_g[i, 0], ln_b[i, 0])
            ctx = layer_norm(DN_ALPHA * ctx + cg2 * peer(modulate(ctx, csh2, csc2), peer_wq[i], peer_keys[i], peer_u[i], peer_v[i]),
                             ln_g[i, 1], ln_b[i, 1])
    return x
```

```cpp
#include <hip/hip_runtime.h>
#include <hip/hip_cooperative_groups.h>
#include <cstdio>
#include <cstdint>
namespace cg = cooperative_groups;

#ifndef FFT_PROBE
#define FFT_PROBE 0
#endif
#ifndef DRY_GATHER
#define DRY_GATHER 0
#endif
#ifndef DUP_MASK
#define DUP_MASK 0
#endif
#ifndef ONE_LAUNCH
#define ONE_LAUNCH 1
#endif

#define LAS __attribute__((address_space(3)))
typedef unsigned short bf16_t;
typedef short bf16x8 __attribute__((ext_vector_type(8)));
typedef short s16x4 __attribute__((ext_vector_type(4)));
typedef float f32x4 __attribute__((ext_vector_type(4)));
typedef float f32x16 __attribute__((ext_vector_type(16)));
typedef float f32x2 __attribute__((ext_vector_type(2)));
typedef unsigned u32x4 __attribute__((ext_vector_type(4)));
typedef unsigned u32x2 __attribute__((ext_vector_type(2)));
typedef short v4i16_t __attribute__((ext_vector_type(4)));

constexpr int D = 1024, NBATCH = 2, SEQ = 16384, NTOK = NBATCH * SEQ;
constexpr int CTXL = 256, NCTX = NBATCH * CTXL;
constexpr int ABIN = 2560, HY3 = 3072, PQN = 2048;
constexpr int NT = 512;
constexpr int LDS_BYTES = 160 * 1024;
constexpr float DN_ALPHA = 1.41421356237309515f;
constexpr float LN_EPS = 1e-5f;

constexpr size_t MiB = 1024 * 1024;
constexpr size_t WS_WIN_T   = 0;
constexpr size_t WS_WOUT_T  = 5 * MiB;
constexpr size_t WS_HYIN_T  = 7 * MiB;
constexpr size_t WS_HYOUT_T = 13 * MiB;
constexpr size_t WS_WK_T    = 15 * MiB;
constexpr size_t WS_WS_BF   = 23 * MiB;
constexpr size_t WS_MOD     = 23 * MiB + 256 * 1024;
constexpr size_t WS_MODC    = WS_MOD + 128 * 1024;
constexpr size_t WS_TWODD   = WS_MODC + 32 * 1024;
constexpr size_t WS_TWS     = WS_TWODD + 128 * 1024;
constexpr size_t WS_BAR     = 23 * MiB + 832 * 1024;
constexpr size_t WS_HID2    = 24 * MiB;
constexpr size_t WS_W3T     = 26 * MiB;
constexpr size_t WS_KVC     = 28 * MiB;
constexpr size_t WS_HCTX    = 29 * MiB;
constexpr size_t WS_HB      = 32 * MiB;
constexpr size_t WS_MIX     = 96 * MiB;
constexpr size_t WS_BIG     = 160 * MiB;
constexpr size_t WS_DQ      = 23 * MiB + 576 * 1024;
constexpr size_t WS_FILT    = 352 * MiB;
constexpr size_t WS_TAB8    = 416 * MiB;
constexpr size_t WS_IDX     = 480 * MiB;
constexpr size_t WS_GATE    = 488 * MiB;
constexpr size_t WS_END     = 512 * MiB;

struct Args {
    const float* in[30];
    float* out;
    unsigned char* ws;
    int ph_lo, ph_hi;
};
enum { I_X = 0, I_C, I_CTX, I_CCTX, I_MODW, I_MODB, I_LNG, I_LNB, I_ABWIN, I_ABWOUT, I_RPB, I_GMWS, I_GMBS, I_HYWIN, I_HYBIN, I_HYCW, I_HYCB,
       I_W1, I_B1, I_F1, I_W2, I_B2, I_F2, I_W3, I_HYD, I_HYWOUT, I_PWQ, I_PKEYS, I_PU, I_PV };

__device__ __forceinline__ unsigned f2bf(float f) { unsigned u = __builtin_bit_cast(unsigned, f); return (u + 0x7fffu + ((u >> 16) & 1u)) >> 16; }
__device__ __forceinline__ float bf2f(unsigned b) { return __builtin_bit_cast(float, (b & 0xffffu) << 16); }
__device__ __forceinline__ unsigned pk2(float lo, float hi) { return f2bf(lo) | (f2bf(hi) << 16); }
__device__ __forceinline__ unsigned cvt_pk_bf16(float lo, float hi) { unsigned r; asm volatile("v_cvt_pk_bf16_f32 %0, %1, %2" : "=v"(r) : "v"(lo), "v"(hi)); return r; }
template <int M> __device__ __forceinline__ float sx(float v) {
    return __builtin_bit_cast(float, __builtin_amdgcn_ds_swizzle(__builtin_bit_cast(int, v), (M << 10) | 0x1f));
}
template <int CTRL> __device__ __forceinline__ float dppx(float v) {
    return __builtin_bit_cast(float, __builtin_amdgcn_update_dpp(0, __builtin_bit_cast(int, v), CTRL, 0xf, 0xf, false));
}
__device__ __forceinline__ float lane_get(float v, int srclane) { return __builtin_bit_cast(float, __builtin_amdgcn_ds_bpermute(srclane << 2, __builtin_bit_cast(int, v))); }
__device__ __forceinline__ int lane_geti(int v, int srclane) { return __builtin_amdgcn_ds_bpermute(srclane << 2, v); }
__device__ __forceinline__ float sx32(float v, int lane) { return lane_get(v, lane ^ 32); }
__device__ __forceinline__ float wave_sum(float v, int lane) { v += sx<1>(v); v += sx<2>(v); v += sx<4>(v); v += sx<8>(v); v += sx<16>(v); v += sx32(v, lane); return v; }
__device__ __forceinline__ float wave_max(float v, int lane) { v = fmaxf(v, sx<1>(v)); v = fmaxf(v, sx<2>(v)); v = fmaxf(v, sx<4>(v)); v = fmaxf(v, sx<8>(v)); v = fmaxf(v, sx<16>(v)); v = fmaxf(v, sx32(v, lane)); return v; }
__device__ __forceinline__ float gelu_erf(float v) { return 0.5f * v * (1.0f + erff(v * 0.70710678118654752f)); }

namespace pg8 {
constexpr int BM = 256, BK = 64, HALF = 128, HTB = HALF * BK * 2, STAGE_BYTES = 8 * HTB, NXCD = 8, WGM = 8;
__host__ __device__ __forceinline__ int lds_byte(int r, int c) { const int st = (r >> 4) * 2 + (c >> 5), rr = r & 15, cc = c & 31, ob = rr * 64 + cc * 2; return st * 1024 + (ob ^ (((ob >> 9) & 1) << 5)); }
__host__ __device__ __forceinline__ void stage_rc(int b, int& R, int& C) { const int st = b / 1024, sb = b % 1024, swz = sb ^ (((sb >> 9) & 1) << 5); R = (st >> 1) * 16 + swz / 64; C = (st & 1) * 32 + (swz % 64) / 2; }
__host__ __device__ __forceinline__ int perm32(int rho) { const int n = rho >> 4, i = rho & 15; return 8 * (i >> 2) + 4 * n + (i & 3); }
struct Unit { int pm, pn; };
struct Gemm { const bf16_t* A; const bf16_t* Bt; int M, N, K; };
struct StaticOrder {
    int nM, nN, nwg, G, c;
    __host__ __device__ void init(int M, int N, int G_, int c_) { nM = M / BM; nN = N / BM; nwg = nM * nN; G = G_; c = c_; }
    __host__ __device__ bool next(int i, Unit& u) const {
        const long L = (long)i * G + c; if (L >= nwg) return false;
        int wgid = (int)L; { const int q = nwg / NXCD, r = nwg % NXCD, xcd = wgid % NXCD, off = wgid / NXCD; wgid = (xcd < r ? xcd * (q + 1) : r * (q + 1) + (xcd - r) * q) + off; }
        const int nig = WGM * nN, gid = wgid / nig, fm = gid * WGM, gsz = (nM - fm) < WGM ? (nM - fm) : WGM;
        u.pm = fm + ((wgid % nig) % gsz); u.pn = (wgid % nig) / gsz; return true;
    }
};

__device__ __forceinline__ f32x2 gelu_pk(f32x2 v) {
    const f32x2 av = __builtin_elementwise_abs(v), d = av * 0.2316418882f + 1.0f;
    f32x2 t; t.x = __builtin_amdgcn_rcpf(d.x); t.y = __builtin_amdgcn_rcpf(d.y);
    f32x2 q = t * 0.5307027145f + (-0.7265760135f); q = q * t + 0.7107068705f; q = q * t + (-0.142248368f); q = q * t + 0.127414796f; q = q * t;
    const f32x2 s = (v * v) * (-0.72134752044f);
    f32x2 e; e.x = __builtin_amdgcn_exp2f(s.x); e.y = __builtin_amdgcn_exp2f(s.y);
    const f32x2 m = v * (q * e), r = v - m;
    f32x2 o; o.x = v.x < 0.f ? m.x : r.x; o.y = v.y < 0.f ? m.y : r.y; return o;
}

struct EpiBf16 {
    static constexpr bool PERM = true;
    bf16_t* O; int ldc; int gelu_from_pn; const float* rowbias;
    __device__ __forceinline__ void operator()(const f32x4 (&acc)[2][2][4][2], const Unit& u, int wr, int wc, int fr, int fq) const {
        const int row0 = u.pm * BM + wr * 64 + fr;
        const int col0 = u.pn * BM + wc * 32 + 8 * fq;
        const bool act = u.pn >= gelu_from_pn;
#pragma unroll
        for (int ai = 0; ai < 2; ++ai)
#pragma unroll
            for (int m = 0; m < 4; ++m) {
                const int row = row0 + ai * HALF + m * 16;
                const float rb = rowbias ? rowbias[row] : 0.f;
                bf16_t* rowp = O + (size_t)row * ldc + col0;
#pragma unroll
                for (int bj = 0; bj < 2; ++bj) {
                    f32x4 v0 = acc[ai][bj][m][0] + rb, v1 = acc[ai][bj][m][1] + rb;
                    if (act) { f32x2 a = gelu_pk((f32x2){v0[0], v0[1]}), b = gelu_pk((f32x2){v0[2], v0[3]}), c = gelu_pk((f32x2){v1[0], v1[1]}), d = gelu_pk((f32x2){v1[2], v1[3]});
                        v0 = (f32x4){a.x, a.y, b.x, b.y}; v1 = (f32x4){c.x, c.y, d.x, d.y}; }
                    u32x4 w; w.x = cvt_pk_bf16(v0[0], v0[1]); w.y = cvt_pk_bf16(v0[2], v0[3]); w.z = cvt_pk_bf16(v1[0], v1[1]); w.w = cvt_pk_bf16(v1[2], v1[3]);
                    *(u32x4*)(rowp + bj * HALF) = w;
                }
            }
    }
};
struct EpiF16 {
    static constexpr bool PERM = true;
    _Float16* O; int ldc;
    __device__ __forceinline__ void operator()(const f32x4 (&acc)[2][2][4][2], const Unit& u, int wr, int wc, int fr, int fq) const {
        typedef _Float16 h8 __attribute__((ext_vector_type(8)));
        const int row0 = u.pm * BM + wr * 64 + fr;
        const int col0 = u.pn * BM + wc * 32 + 8 * fq;
#pragma unroll
        for (int ai = 0; ai < 2; ++ai)
#pragma unroll
            for (int m = 0; m < 4; ++m) {
                _Float16* rowp = O + (size_t)(row0 + ai * HALF + m * 16) * ldc + col0;
#pragma unroll
                for (int bj = 0; bj < 2; ++bj) {
                    const f32x4 v0 = acc[ai][bj][m][0], v1 = acc[ai][bj][m][1];
                    h8 w; w[0] = (_Float16)v0[0]; w[1] = (_Float16)v0[1]; w[2] = (_Float16)v0[2]; w[3] = (_Float16)v0[3];
                    w[4] = (_Float16)v1[0]; w[5] = (_Float16)v1[1]; w[6] = (_Float16)v1[2]; w[7] = (_Float16)v1[3];
                    *(h8*)(rowp + bj * HALF) = w;
                }
            }
    }
};
struct EpiRes {
    static constexpr bool PERM = false;
    const float* res; float* out; const float* gate;
    __device__ __forceinline__ void operator()(const f32x4 (&acc)[2][2][4][2], const Unit& u, int wr, int wc, int fr, int fq) const {
        const int rowt = u.pm * BM;
        const float* g = gate + (size_t)(rowt / SEQ) * 6144;
        const int col0 = u.pn * BM + wc * 32 + 4 * fq;
#pragma unroll
        for (int bj = 0; bj < 2; ++bj)
#pragma unroll
            for (int n = 0; n < 2; ++n) {
                const int col = col0 + bj * HALF + n * 16;
                const f32x4 gv = *(const f32x4*)(g + col);
#pragma unroll
                for (int ai = 0; ai < 2; ++ai)
#pragma unroll
                    for (int m = 0; m < 4; ++m) {
                        const size_t off = (size_t)(rowt + ai * HALF + wr * 64 + m * 16 + fr) * D + col;
                        const f32x4 rv = *(const f32x4*)(res + off);
                        *(f32x4*)(out + off) = rv * DN_ALPHA + gv * acc[ai][bj][m][n];
                    }
            }
    }
};

template <class Epi, class Sched, bool ALIGN_EPI = false, bool SP2 = false>
__device__ __forceinline__ void gemm_phase(LAS unsigned char* lds, const Gemm g, const Sched& S, const Epi& E, const int tid) {
    const int wid = __builtin_amdgcn_readfirstlane(tid >> 6), lane = tid & 63, wr = wid >> 2, wc = wid & 3, fr = lane & 15, fq = lane >> 4;
    const int K = g.K, nt = K / BK;
    unsigned voffA[2], voffB[2];
#pragma unroll
    for (int i = 0; i < 2; ++i) { int R, C; stage_rc(tid * 16 + i * 8192, R, C); const int Rb = Epi::PERM ? ((R & ~31) + perm32(R & 31)) : R;
        voffA[i] = (unsigned)(R * K + C) * 2u; voffB[i] = (unsigned)(Rb * K + C) * 2u; }
    const size_t kstep = (size_t)(BK * 2);
    const size_t hstep = (size_t)HALF * K * 2;
    const size_t tstep = 2 * hstep;
    const unsigned ldsw = (unsigned)wid * 1024u;
    const int aoff = lds_byte(wr * 64 + fr, fq * 8), boff = lds_byte(wc * 32 + fr, fq * 8);
#define PG8_SA(b, h) (((b) * 2 + (h)) * HTB)
#define PG8_SB(b, h) ((4 + (b) * 2 + (h)) * HTB)
#define PG8_STAGE(bufoff, gbase, voff) do { _Pragma("unroll") for (int _i = 0; _i < 2; ++_i) \
        __builtin_amdgcn_global_load_lds((const unsigned*)((const char*)(gbase) + (voff)[_i]), (LAS unsigned*)(lds + (bufoff) + ldsw + _i * 8192), 16, 0, 0); } while (0)
#define PG8_LDA(dst, b, h) do { _Pragma("unroll") for (int m = 0; m < 4; ++m) _Pragma("unroll") for (int k = 0; k < 2; ++k) dst[m][k] = *(const LAS bf16x8*)(lds + PG8_SA(b, h) + aoff + m * 2048 + k * 1024); } while (0)
#define PG8_LDB(dst, b, h) do { _Pragma("unroll") for (int n = 0; n < 2; ++n) _Pragma("unroll") for (int k = 0; k < 2; ++k) dst[n][k] = *(const LAS bf16x8*)(lds + PG8_SB(b, h) + boff + n * 2048 + k * 1024); } while (0)
#define PG8_MMA(ai, bj, At, Bt) do { __builtin_amdgcn_s_setprio(1); _Pragma("unroll") for (int m = 0; m < 4; ++m) _Pragma("unroll") for (int n = 0; n < 2; ++n) _Pragma("unroll") for (int k = 0; k < 2; ++k) \
        acc[ai][bj][m][n] = __builtin_amdgcn_mfma_f32_16x16x32_bf16(Bt[n][k], At[m][k], acc[ai][bj][m][n], 0, 0, 0); __builtin_amdgcn_s_setprio(0); } while (0)
#define PG8_WAIT_V(n) asm volatile("s_waitcnt vmcnt(" #n ")" ::: "memory")
#define PG8_WAIT_L(n) asm volatile("s_waitcnt lgkmcnt(" #n ")" ::: "memory")
#define PG8_BAR __builtin_amdgcn_s_barrier()
#define PG8_SCHED __builtin_amdgcn_sched_barrier(0)
    Unit cur, nxt; int ui = 0;
    if (!S.next(0, cur)) return;
    f32x4 acc[2][2][4][2];
#pragma unroll
    for (int a = 0; a < 2; ++a)
#pragma unroll
        for (int b = 0; b < 2; ++b)
#pragma unroll
            for (int m = 0; m < 4; ++m)
#pragma unroll
                for (int n = 0; n < 2; ++n) acc[a][b][m][n] = (f32x4){0.f, 0.f, 0.f, 0.f};
    bf16x8 At[4][2], B0[2][2], B1[2][2];
    const char* cA = (const char*)g.A + (size_t)cur.pm * tstep; const char* cB = (const char*)g.Bt + (size_t)cur.pn * tstep;
    if constexpr (SP2) {
        PG8_STAGE(PG8_SB(0, 0), cB, voffB); PG8_STAGE(PG8_SB(0, 1), cB + hstep, voffB); PG8_STAGE(PG8_SA(0, 0), cA, voffA); PG8_STAGE(PG8_SA(0, 1), cA + hstep, voffA);
        if (wr == 1) PG8_BAR;
        PG8_WAIT_V(2); PG8_BAR;
        PG8_STAGE(PG8_SB(1, 0), cB + kstep, voffB); PG8_STAGE(PG8_SA(1, 0), cA + kstep, voffA); PG8_STAGE(PG8_SB(1, 1), cB + hstep + kstep, voffB);
        PG8_WAIT_V(6); PG8_BAR;
    } else {
        PG8_STAGE(PG8_SB(0, 0), cB, voffB); PG8_STAGE(PG8_SA(0, 0), cA, voffA); PG8_STAGE(PG8_SB(0, 1), cB + hstep, voffB); PG8_STAGE(PG8_SA(0, 1), cA + hstep, voffA);
        if (wr == 1) PG8_BAR;
        PG8_WAIT_V(4); PG8_BAR;
        PG8_STAGE(PG8_SB(1, 0), cB + kstep, voffB); PG8_STAGE(PG8_SA(1, 0), cA + kstep, voffA); PG8_STAGE(PG8_SB(1, 1), cB + hstep + kstep, voffB);
        PG8_WAIT_V(6); PG8_BAR;
    }
    for (;;) {
        const bool has_next = S.next(ui + 1, nxt);
        const char* nA = has_next ? (const char*)g.A + (size_t)nxt.pm * tstep : cA; const char* nB = has_next ? (const char*)g.Bt + (size_t)nxt.pn * tstep : cB;
        for (int t = 0; t < nt; t += 2) {
            const bool last = (t == nt - 2);
            const char* a1 = cA + (size_t)(t + 1) * kstep;
            const char* a2 = last ? nA : cA + (size_t)(t + 2) * kstep; const char* b2 = last ? nB : cB + (size_t)(t + 2) * kstep;
            const char* a3 = a2 + kstep; const char* b3 = b2 + kstep;
            if constexpr (SP2) {
            PG8_LDB(B0, 0, 0); PG8_LDB(B1, 0, 1); PG8_SCHED; PG8_LDA(At, 0, 0); PG8_STAGE(PG8_SA(1, 1), a1 + hstep, voffA);
            PG8_WAIT_V(8); PG8_WAIT_L(0); PG8_BAR; PG8_MMA(0, 0, At, B0); PG8_MMA(0, 1, At, B1); PG8_BAR; PG8_SCHED;
            PG8_LDA(At, 0, 1); PG8_STAGE(PG8_SB(0, 0), b2, voffB); PG8_STAGE(PG8_SB(0, 1), b2 + hstep, voffB); PG8_STAGE(PG8_SA(0, 0), a2, voffA);
            PG8_WAIT_V(8); PG8_WAIT_L(0); PG8_BAR; PG8_MMA(1, 0, At, B0); PG8_MMA(1, 1, At, B1); PG8_BAR; PG8_SCHED;
            PG8_LDB(B0, 1, 0); PG8_LDB(B1, 1, 1); PG8_SCHED; PG8_LDA(At, 1, 0); PG8_STAGE(PG8_SA(0, 1), a2 + hstep, voffA);
            PG8_WAIT_V(8); PG8_WAIT_L(0); PG8_BAR; PG8_MMA(0, 0, At, B0); PG8_MMA(0, 1, At, B1); PG8_BAR; PG8_SCHED;
            PG8_LDA(At, 1, 1); PG8_STAGE(PG8_SB(1, 0), b3, voffB); PG8_STAGE(PG8_SB(1, 1), b3 + hstep, voffB); PG8_STAGE(PG8_SA(1, 0), a3, voffA);
            PG8_WAIT_V(8); PG8_WAIT_L(0); PG8_BAR; PG8_MMA(1, 0, At, B0); PG8_MMA(1, 1, At, B1); PG8_BAR; PG8_SCHED;
            } else {
            PG8_LDB(B0, 0, 0); PG8_SCHED; PG8_LDA(At, 0, 0); PG8_STAGE(PG8_SA(1, 1), a1 + hstep, voffA);
            PG8_WAIT_L(8); PG8_BAR; PG8_WAIT_L(0); PG8_MMA(0, 0, At, B0); PG8_BAR; PG8_SCHED;
            PG8_LDB(B1, 0, 1); PG8_STAGE(PG8_SB(0, 0), b2, voffB);
            PG8_BAR; PG8_WAIT_L(0); PG8_MMA(0, 1, At, B1); PG8_BAR;
            PG8_LDA(At, 0, 1); PG8_STAGE(PG8_SA(0, 0), a2, voffA);
            PG8_BAR; PG8_WAIT_L(0); PG8_MMA(1, 0, At, B0); PG8_BAR; PG8_SCHED;
            PG8_STAGE(PG8_SB(0, 1), b2 + hstep, voffB);
            PG8_WAIT_V(6); PG8_BAR; PG8_MMA(1, 1, At, B1); PG8_BAR;
            PG8_LDB(B0, 1, 0); PG8_SCHED; PG8_LDA(At, 1, 0); PG8_STAGE(PG8_SA(0, 1), a2 + hstep, voffA);
            PG8_WAIT_L(8); PG8_BAR; PG8_WAIT_L(0); PG8_MMA(0, 0, At, B0); PG8_BAR; PG8_SCHED;
            PG8_LDB(B1, 1, 1); PG8_STAGE(PG8_SB(1, 0), b3, voffB);
            PG8_BAR; PG8_WAIT_L(0); PG8_MMA(0, 1, At, B1); PG8_BAR;
            PG8_LDA(At, 1, 1); PG8_STAGE(PG8_SA(1, 0), a3, voffA);
            PG8_BAR; PG8_WAIT_L(0); PG8_MMA(1, 0, At, B0); PG8_BAR; PG8_SCHED;
            PG8_STAGE(PG8_SB(1, 1), b3 + hstep, voffB);
            PG8_WAIT_V(6); PG8_BAR; PG8_MMA(1, 1, At, B1); PG8_BAR;
            }
        }
        if constexpr (ALIGN_EPI) { if (wr == 0) PG8_BAR; }
        E(acc, cur, wr, wc, fr, fq);
        if (!has_next) break;
#pragma unroll
        for (int a = 0; a < 2; ++a)
#pragma unroll
            for (int b = 0; b < 2; ++b)
#pragma unroll
                for (int m = 0; m < 4; ++m)
#pragma unroll
                    for (int n = 0; n < 2; ++n) acc[a][b][m][n] = (f32x4){0.f, 0.f, 0.f, 0.f};
        cur = nxt; cA = nA; cB = nB; ++ui;
        if constexpr (ALIGN_EPI) { if (wr == 1) PG8_BAR; }
    }
    PG8_WAIT_V(0);
    if constexpr (!ALIGN_EPI) { if (wr == 0) PG8_BAR; }
    PG8_BAR;
#undef PG8_SA
#undef PG8_SB
#undef PG8_STAGE
#undef PG8_LDA
#undef PG8_LDB
#undef PG8_MMA
#undef PG8_WAIT_V
#undef PG8_WAIT_L
#undef PG8_BAR
#undef PG8_SCHED
}
}

struct Ctx {
    const Args* a; LAS unsigned char* lds; int tid, lane, wave, G, bid;
    template <class T> __device__ __forceinline__ T* ws(size_t off) const { return (T*)(a->ws + off); }
    __device__ __forceinline__ const float* in(int i) const { return a->in[i]; }
};

__device__ void transpose_cvt(const Ctx& c, const float* in, bf16_t* out, int K, int N) {
    LAS float* t = (LAS float*)c.lds;
    const int tk = K / 64, tn = N / 64;
    for (int tile = c.bid; tile < tk * tn; tile += c.G) {
        const int k0 = (tile / tn) * 64, n0 = (tile % tn) * 64;
        __syncthreads();
#pragma unroll
        for (int i = 0; i < 8; ++i) { const int e = c.tid + i * NT, r = e >> 6, cc = e & 63; t[r * 65 + cc] = in[(size_t)(k0 + r) * N + n0 + cc]; }
        __syncthreads();
#pragma unroll
        for (int i = 0; i < 8; ++i) { const int e = c.tid + i * NT, r = e >> 6, cc = e & 63; out[(size_t)(n0 + r) * K + k0 + cc] = (bf16_t)f2bf(t[cc * 65 + r]); }
    }
    __syncthreads();
}

__device__ void phase_prep(const Ctx& c) {
    transpose_cvt(c, c.in(I_ABWIN), c.ws<bf16_t>(WS_WIN_T), D, ABIN);
    transpose_cvt(c, c.in(I_ABWOUT), c.ws<bf16_t>(WS_WOUT_T), D, D);
    transpose_cvt(c, c.in(I_HYWIN), c.ws<bf16_t>(WS_HYIN_T), D, HY3);
    transpose_cvt(c, c.in(I_HYWOUT), c.ws<bf16_t>(WS_HYOUT_T), D, D);
    {
        LAS float* sv = (LAS float*)c.lds;
        LAS float* red = sv + 3 * 1024;
        __syncthreads();
        for (int e = c.tid; e < 3 * 1024; e += NT) { const int w = e >> 10, k = e & 1023; const float v = w < 2 ? c.in(I_C)[w * D + k] : c.in(I_CCTX)[k]; sv[e] = v / (1.0f + __expf(-v)); }
        __syncthreads();
        const int jj = c.tid & 63, kg = c.tid >> 6;
        for (int item = c.bid; item < 2 * 96; item += c.G) {
            const int layer = item / 96, j = (item % 96) * 64 + jj;
            const float* w = c.in(I_MODW) + (size_t)layer * D * 6144 + j;
            float a0 = 0.f, a1 = 0.f, a2 = 0.f;
#pragma unroll 8
            for (int kk = 0; kk < 128; ++kk) { const int k = kg * 128 + kk; const float wv = w[(size_t)k * 6144]; a0 += sv[k] * wv; a1 += sv[1024 + k] * wv; a2 += sv[2048 + k] * wv; }
            red[(0 * 8 + kg) * 64 + jj] = a0; red[(1 * 8 + kg) * 64 + jj] = a1; red[(2 * 8 + kg) * 64 + jj] = a2;
            __syncthreads();
            if (c.tid < 192) { const int w3 = c.tid >> 6; float s = 0.f;
#pragma unroll
                for (int q = 0; q < 8; ++q) s += red[(w3 * 8 + q) * 64 + jj];
                s += c.in(I_MODB)[layer * 6144 + j];
                if (w3 < 2) c.ws<float>(WS_MOD)[(layer * 2 + w3) * 6144 + j] = s; else if (layer == 0) c.ws<float>(WS_MODC)[j] = s; }
            __syncthreads();
        }
    }
    {
        LAS float* z = (LAS float*)c.lds;
        LAS float* h1 = z + 8 * 40;
        const int tt = c.tid >> 6, j = c.tid & 63;
        for (int item = c.bid; item < SEQ / 8; item += c.G) {
            __syncthreads();
            if (c.tid < 8 * 33) { const int t8 = c.tid / 33, e = c.tid % 33, t = item * 8 + t8; float v;
                if (e == 0) v = (float)((double)t / (double)(SEQ - 1));
                else { const int k = (e - 1) & 15; const double band = 1e-4 + (double)k * ((15.0 - 1e-4) / 15.0); const double rev = 2.0 * band * (double)t / (double)SEQ;
                    v = (e <= 16) ? (float)cospi(rev) : (float)(-sinpi(rev)); }
                z[t8 * 40 + e] = v; }
            __syncthreads();
            { float s = c.in(I_B1)[j];
#pragma unroll
              for (int e = 0; e < 33; ++e) s += z[tt * 40 + e] * c.in(I_W1)[e * 64 + j];
              h1[tt * 64 + j] = sinf(c.in(I_F1)[j] * s); }
            __syncthreads();
            { float s = c.in(I_B2)[j];
#pragma unroll 8
              for (int m = 0; m < 64; ++m) s += h1[tt * 64 + m] * c.in(I_W2)[m * 64 + j];
              c.ws<bf16_t>(WS_HID2)[(size_t)(item * 8 + tt) * 64 + j] = (bf16_t)f2bf(sinf(c.in(I_F2)[j] * s)); }
        }
        __syncthreads();
    }
    {
        LAS bf16_t* kyb = (LAS bf16_t*)c.lds;
        LAS bf16_t* wqb = kyb + 128 * 136;
        const int l31 = c.lane & 31, hh = c.lane >> 5;
        for (int item = c.bid; item < 2 * 16 * 8; item += c.G) {
            const int layer = item / 128, hp = (item / 8) % 16, kt = item % 8;
            __syncthreads();
#pragma unroll
            for (int i = 0; i < 8; ++i) { const int idx = c.tid + i * NT, r = idx >> 5, q4 = (idx & 31) * 4;
                const f32x4 kv = *(const f32x4*)(c.in(I_PKEYS) + (((size_t)layer * 16 + hp) * 128 + r) * 128 + q4);
                const f32x4 wv = *(const f32x4*)(c.in(I_PWQ) + ((size_t)layer * D + kt * 128 + r) * PQN + hp * 128 + q4);
                *(LAS u32x2*)(kyb + r * 136 + q4) = (u32x2){pk2(kv[0], kv[1]), pk2(kv[2], kv[3])};
                *(LAS u32x2*)(wqb + r * 136 + q4) = (u32x2){pk2(wv[0], wv[1]), pk2(wv[2], wv[3])}; }
            __syncthreads();
            const int mt = c.wave & 3, ntb = (c.wave >> 2) * 2;
            f32x16 acc[2];
#pragma unroll
            for (int j = 0; j < 2; ++j)
#pragma unroll
                for (int i = 0; i < 16; ++i) acc[j][i] = 0.f;
#pragma unroll
            for (int ks = 0; ks < 8; ++ks) {
                const bf16x8 af = *(const LAS bf16x8*)(kyb + (mt * 32 + l31) * 136 + ks * 16 + hh * 8);
#pragma unroll
                for (int j = 0; j < 2; ++j) { const bf16x8 bfr = *(const LAS bf16x8*)(wqb + ((ntb + j) * 32 + l31) * 136 + ks * 16 + hh * 8);
                    acc[j] = __builtin_amdgcn_mfma_f32_32x32x16_bf16(af, bfr, acc[j], 0, 0, 0); }
            }
            bf16_t* o = c.ws<bf16_t>(WS_WK_T) + ((size_t)layer * PQN + hp * 128) * D + kt * 128;
#pragma unroll
            for (int j = 0; j < 2; ++j)
#pragma unroll
                for (int i = 0; i < 16; ++i) { const int key = mt * 32 + (i & 3) + 8 * (i >> 2) + 4 * hh;
                    o[(size_t)key * D + (ntb + j) * 32 + l31] = (bf16_t)f2bf(acc[j][i]); }
        }
        __syncthreads();
    }
    for (int e = c.bid * NT + c.tid; e < 4 * 128 * 128; e += c.G * NT) c.ws<bf16_t>(WS_WS_BF)[e] = (bf16_t)f2bf(c.in(I_GMWS)[e]);
    for (int e = c.bid * NT + c.tid; e < 64 * 2048; e += c.G * NT) { const int j = e >> 11, col = e & 2047; c.ws<bf16_t>(WS_W3T)[col * 64 + j] = (bf16_t)f2bf(c.in(I_W3)[e]); }
    for (int e = c.bid * NT + c.tid; e < 16384 + 1024 + 64 + 4; e += c.G * NT) {
        double rev; f32x2* dst;
        if (e < 16384) { rev = (double)e / 32768.0; dst = c.ws<f32x2>(WS_TWODD) + e; }
        else if (e < 16384 + 1024) { rev = (double)(e - 16384) / 16384.0; dst = c.ws<f32x2>(WS_TWS) + (e - 16384); }
        else if (e < 16384 + 1024 + 64) { rev = (double)(e - 17408) / 1024.0; dst = c.ws<f32x2>(WS_TWS) + (e - 16384); }
        else { rev = (double)(e - 17472) / 64.0; dst = c.ws<f32x2>(WS_TWS) + (e - 16384); }
        double sn, cs; sincospi(-2.0 * rev, &sn, &cs);
        *dst = (f32x2){(float)cs, (float)sn};
    }
    {
        typedef float v16f __attribute__((ext_vector_type(16)));
        typedef unsigned v6u __attribute__((ext_vector_type(6)));
        const int hh = c.lane >> 5, r = c.lane & 31;
        for (int row0 = (c.bid * 8 + c.wave) * 4; row0 < 4 * 16384; row0 += c.G * 8 * 4) {
            f32x4 v[2][8]; float mx[2];
#pragma unroll
            for (int q = 0; q < 2; ++q) { const int row = row0 + 2 * q + hh, which = row >> 14, rr = row & 16383, layer = which >> 1;
                const float* src = ((which & 1) ? c.in(I_PV) : c.in(I_PU)) + ((size_t)layer * 16384 + rr) * D + 4 * r;
#pragma unroll
                for (int m = 0; m < 8; ++m) v[q][m] = __builtin_nontemporal_load((const f32x4*)(src + 128 * m)); }
#pragma unroll
            for (int q = 0; q < 2; ++q) { float x = 0.f;
#pragma unroll
                for (int m = 0; m < 8; ++m) x = fmaxf(x, fmaxf(fmaxf(fabsf(v[q][m][0]), fabsf(v[q][m][1])), fmaxf(fabsf(v[q][m][2]), fabsf(v[q][m][3]))));
                mx[q] = x; }
#pragma unroll
            for (int q = 0; q < 2; ++q) { float x = mx[q]; x = fmaxf(x, sx<16>(x)); x = fmaxf(x, sx<8>(x)); x = fmaxf(x, sx<4>(x)); x = fmaxf(x, sx<2>(x)); x = fmaxf(x, sx<1>(x)); mx[q] = x; }
#pragma unroll
            for (int q = 0; q < 2; ++q) { const int row = row0 + 2 * q + hh; const float m1 = fmaxf(mx[q], 1e-30f), sc = 7.0f / m1;
                v16f a, bb;
#pragma unroll
                for (int i = 0; i < 16; ++i) { a[i] = v[q][i >> 1][2 * (i & 1)] * sc; bb[i] = v[q][i >> 1][2 * (i & 1) + 1] * sc; }
                const v6u p = __builtin_amdgcn_cvt_scalef32_2xpk16_fp6_f32(a, bb, 1.0f);
                unsigned char* dst = c.ws<unsigned char>(WS_TAB8) + (size_t)row * 768 + 24 * r;
                *(u32x2*)dst = (u32x2){p[0], p[1]}; *(u32x2*)(dst + 8) = (u32x2){p[2], p[3]}; *(u32x2*)(dst + 16) = (u32x2){p[4], p[5]};
                if (r == 0) c.ws<float>(WS_DQ)[(((row >> 15) * 16384) + (row & 16383)) * 2 + ((row >> 14) & 1)] = m1 * (1.0f / 7.0f); }
        }
    }
}

__device__ void modulate_rows(const Ctx& c, const float* x, bf16_t* out, int rows, int rows_per_batch, const float* sh, const float* sc, int bstride) {
    const int total = rows * (D / 8);
    for (int e = c.bid * NT + c.tid; e < total; e += c.G * NT) {
        const int r = e >> 7, c8 = (e & 127) * 8, b = r / rows_per_batch;
        const f32x4 x0 = *(const f32x4*)(x + (size_t)r * D + c8), x1 = *(const f32x4*)(x + (size_t)r * D + c8 + 4);
        const f32x4 s0 = *(const f32x4*)(sc + b * bstride + c8), s1 = *(const f32x4*)(sc + b * bstride + c8 + 4);
        const f32x4 h0 = *(const f32x4*)(sh + b * bstride + c8), h1 = *(const f32x4*)(sh + b * bstride + c8 + 4);
        const f32x4 y0 = x0 * (s0 + 1.0f) + h0, y1 = x1 * (s1 + 1.0f) + h1;
        u32x4 w; w.x = pk2(y0[0], y0[1]); w.y = pk2(y0[2], y0[3]); w.z = pk2(y1[0], y1[1]); w.w = pk2(y1[2], y1[3]);
        *(u32x4*)(out + (size_t)r * D + c8) = w;
    }
}

__device__ void phase_mod0_filt(const Ctx& c) {
    const float* mod0 = c.ws<float>(WS_MOD);
    modulate_rows(c, c.in(I_X), c.ws<bf16_t>(WS_HB), NTOK, SEQ, mod0, mod0 + 1024, 6144);
    const float* modc = c.ws<float>(WS_MODC);
    modulate_rows(c, c.in(I_CTX), c.ws<bf16_t>(WS_HCTX), NCTX, NCTX, modc, modc + 1024, 0);
    {
        const bf16_t* W3T = c.ws<bf16_t>(WS_W3T); const bf16_t* H2 = c.ws<bf16_t>(WS_HID2); bf16_t* FILT = c.ws<bf16_t>(WS_FILT);
        const int l31 = c.lane & 31, hh = c.lane >> 5;
        const float d0 = 3.0701134573253943f, d1 = 15.350567286626972f;
        for (int item = c.bid * 8 + c.wave; item < 64 * 512; item += c.G * 8) {
            const int col0 = (item >> 9) * 32, t0 = (item & 511) * 32;
            f32x16 acc;
#pragma unroll
            for (int i = 0; i < 16; ++i) acc[i] = 0.f;
#pragma unroll
            for (int ks = 0; ks < 4; ++ks) {
                const bf16x8 af = *(const bf16x8*)(W3T + (size_t)(col0 + l31) * 64 + ks * 16 + hh * 8);
                const bf16x8 bfr = *(const bf16x8*)(H2 + (size_t)(t0 + l31) * 64 + ks * 16 + hh * 8);
                acc = __builtin_amdgcn_mfma_f32_32x32x16_bf16(af, bfr, acc, 0, 0, 0);
            }
            const int t = t0 + l31;
            const float tn = (float)t * (1.0f / (float)(SEQ - 1));
#pragma unroll
            for (int i = 0; i < 16; ++i) { const int col = col0 + (i & 3) + 8 * (i >> 2) + 4 * hh, ch = col & 1023;
                const float delta = d0 + (float)ch * ((d1 - d0) / 1023.0f);
                const float val = acc[i] * __expf(-tn * delta);
                if (col < 1024) FILT[(size_t)ch * SEQ + t] = (bf16_t)f2bf(val);
                else FILT[(size_t)(1024 + ch) * SEQ + ((SEQ - t) & (SEQ - 1))] = (bf16_t)(t ? f2bf(val) : 0u); }
        }
    }
}

__device__ void phase_attn(const Ctx& c) {
    LAS float* rpb = (LAS float*)c.lds + 64;
    LAS unsigned char* vt = c.lds + 16384 + c.wave * 6144;
    __syncthreads();
    for (int e = c.tid; e < 8 * 15 * 31; e += NT) rpb[e] = c.in(I_RPB)[e] * 1.44269504088896341f;
    __syncthreads();
    const bf16_t* P = c.ws<bf16_t>(WS_BIG);
    const bf16_t* KVC = c.ws<bf16_t>(WS_KVC);
    bf16_t* MIXO = c.ws<bf16_t>(WS_MIX);
    const int lane = c.lane, h = c.wave, l31 = lane & 31, hh = lane >> 5;
    const int gg = lane >> 4, li = lane & 15;
    for (int item = c.bid; item < NBATCH * 256; item += c.G) {
        const int b = item >> 8, r = item & 255;
        const int rs = min(max(r - 4, 0), 248);
        const size_t tok0 = (size_t)b * SEQ + (size_t)r * 64;
        bf16x8 qf[2][4];
#pragma unroll
        for (int nt = 0; nt < 2; ++nt)
#pragma unroll
            for (int s = 0; s < 4; ++s) qf[nt][s] = *(const bf16x8*)(P + (tok0 + nt * 32 + l31) * ABIN + h * 64 + s * 16 + hh * 8);
        f32x16 o[2][2];
#pragma unroll
        for (int nt = 0; nt < 2; ++nt)
#pragma unroll
            for (int mt = 0; mt < 2; ++mt)
#pragma unroll
                for (int i = 0; i < 16; ++i) o[nt][mt][i] = 0.f;
        float mrun[2] = {-1e30f, -1e30f}, lrun[2] = {0.f, 0.f};
        for (int kt = 0; kt < 24; ++kt) {
            const bool isctx = kt < 8;
            const bf16_t *kbase, *vbase; size_t kstride; int rr = 0, c0 = 0;
            if (isctx) { const size_t row0 = (size_t)b * CTXL + kt * 32; kbase = KVC + row0 * 1024 + h * 64; vbase = kbase + 512; kstride = 1024; }
            else { const int lt = kt - 8; rr = rs + (lt >> 1); c0 = (lt & 1) * 32; const size_t row0 = (size_t)b * SEQ + (size_t)rr * 64 + c0; kbase = P + row0 * ABIN + 512 + h * 64; vbase = kbase + 512; kstride = ABIN; }
#pragma unroll
            for (int it = 0; it < 4; ++it) { const int key = it * 8 + (lane >> 3), ch = lane & 7;
                const u32x4 v = *(const u32x4*)(vbase + (size_t)key * kstride + ch * 8);
                *(LAS u32x4*)(vt + key * 192 + ch * 16) = v; }
            bf16x8 kf[4];
#pragma unroll
            for (int s = 0; s < 4; ++s) kf[s] = *(const bf16x8*)(kbase + (size_t)l31 * kstride + s * 16 + hh * 8);
            bf16x8 pf[2][2];
#pragma unroll
            for (int nt = 0; nt < 2; ++nt) {
                f32x16 st;
#pragma unroll
                for (int i = 0; i < 16; ++i) st[i] = 0.f;
#pragma unroll
                for (int s = 0; s < 4; ++s) st = __builtin_amdgcn_mfma_f32_32x32x16_bf16(kf[s], qf[nt][s], st, 0, 0, 0);
                float mx = -INFINITY;
                if (isctx) {
#pragma unroll
                    for (int i = 0; i < 16; ++i) { st[i] *= 0.125f * 1.44269504088896341f; mx = fmaxf(mx, st[i]); }
                } else {
                    const int qc = nt * 32 + l31, cs = min(max(qc - 8, 0), 48);
                    const LAS float* rp = rpb + (h * 15 + (rr - r + 7)) * 31 + 15 - qc + c0 + 4 * hh;
                    const unsigned kb = (unsigned)(c0 + 4 * hh - cs);
                    float bias[16];
#pragma unroll
                    for (int i = 0; i < 16; ++i) bias[i] = rp[(i & 3) + 8 * (i >> 2)];
#pragma unroll
                    for (int i = 0; i < 16; ++i) asm volatile("" : "+v"(bias[i]));
#pragma unroll
                    for (int i = 0; i < 16; ++i) { const bool valid = (kb + (unsigned)((i & 3) + 8 * (i >> 2))) < 16u;
                        st[i] = valid ? st[i] * (0.125f * 1.44269504088896341f) + bias[i] : -INFINITY; mx = fmaxf(mx, st[i]); }
                }
                mx = fmaxf(mx, sx32(mx, lane));
                if (__builtin_amdgcn_ballot_w64(mx > mrun[nt] + 8.0f) != 0ull) {
                    const float mnew = fmaxf(mrun[nt], mx), alpha = __builtin_amdgcn_exp2f(mrun[nt] - mnew);
                    lrun[nt] *= alpha; mrun[nt] = mnew;
#pragma unroll
                    for (int mt = 0; mt < 2; ++mt)
#pragma unroll
                        for (int i = 0; i < 16; ++i) o[nt][mt][i] *= alpha;
                }
                float ls = 0.f;
#pragma unroll
                for (int i = 0; i < 16; ++i) { st[i] = __builtin_amdgcn_exp2f(st[i] - mrun[nt]); ls += st[i]; }
                ls += sx32(ls, lane);
                lrun[nt] += ls;
#pragma unroll
                for (int s2 = 0; s2 < 2; ++s2) { u32x4 w; w.x = cvt_pk_bf16(st[8 * s2], st[8 * s2 + 1]); w.y = cvt_pk_bf16(st[8 * s2 + 2], st[8 * s2 + 3]);
                    w.z = cvt_pk_bf16(st[8 * s2 + 4], st[8 * s2 + 5]); w.w = cvt_pk_bf16(st[8 * s2 + 6], st[8 * s2 + 7]); pf[nt][s2] = __builtin_bit_cast(bf16x8, w); }
            }
#pragma unroll
            for (int mt = 0; mt < 2; ++mt)
#pragma unroll
                for (int s2 = 0; s2 < 2; ++s2) {
                    const int key0 = 16 * s2 + 4 * hh + (li >> 2), colb = (mt * 32 + 16 * (gg & 1) + 4 * (li & 3)) * 2;
                    const s16x4 lo = __builtin_bit_cast(s16x4, __builtin_amdgcn_ds_read_tr16_b64_v4i16((LAS v4i16_t*)(vt + key0 * 192 + colb)));
                    const s16x4 hi = __builtin_bit_cast(s16x4, __builtin_amdgcn_ds_read_tr16_b64_v4i16((LAS v4i16_t*)(vt + (key0 + 8) * 192 + colb)));
                    bf16x8 vf; vf[0] = lo[0]; vf[1] = lo[1]; vf[2] = lo[2]; vf[3] = lo[3]; vf[4] = hi[0]; vf[5] = hi[1]; vf[6] = hi[2]; vf[7] = hi[3];
#pragma unroll
                    for (int nt = 0; nt < 2; ++nt) o[nt][mt] = __builtin_amdgcn_mfma_f32_32x32x16_bf16(vf, pf[nt][s2], o[nt][mt], 0, 0, 0);
                }
        }
#pragma unroll
        for (int nt = 0; nt < 2; ++nt) {
            const float inv = 1.0f / lrun[nt];
            bf16_t* op = MIXO + (tok0 + nt * 32 + l31) * D + h * 64;
#pragma unroll
            for (int mt = 0; mt < 2; ++mt)
#pragma unroll
                for (int gi = 0; gi < 4; ++gi) { u32x2 w; w.x = cvt_pk_bf16(o[nt][mt][4 * gi] * inv, o[nt][mt][4 * gi + 1] * inv); w.y = cvt_pk_bf16(o[nt][mt][4 * gi + 2] * inv, o[nt][mt][4 * gi + 3] * inv);
                    *(u32x2*)(op + mt * 32 + 8 * gi + 4 * hh) = w; }
        }
    }
    __syncthreads();
}

__device__ void phase_gating(const Ctx& c) {
    constexpr int RS = 1088;
    const bf16_t* P = c.ws<bf16_t>(WS_BIG);
    bf16_t* MIXO = c.ws<bf16_t>(WS_MIX);
    const bf16_t* WS = c.ws<bf16_t>(WS_WS_BF);
    const float* BS = c.in(I_GMBS);
    const int lane = c.lane, l31 = lane & 31, hh = lane >> 5, gg = lane >> 4, li = lane & 15;
    for (int item = c.bid; item < NTOK / 128; item += c.G) {
        const size_t tok0 = (size_t)item * 128;
        __syncthreads();
        for (int rw = 0; rw < 16; ++rw) {
            const int row = c.wave * 16 + rw;
            const u32x4 raw = *(const u32x4*)(P + (tok0 + row) * ABIN + 2048 + lane * 8);
            float v[8]; v[0] = bf2f(raw.x); v[1] = bf2f(raw.x >> 16); v[2] = bf2f(raw.y); v[3] = bf2f(raw.y >> 16); v[4] = bf2f(raw.z); v[5] = bf2f(raw.z >> 16); v[6] = bf2f(raw.w); v[7] = bf2f(raw.w >> 16);
            float s = 0.f;
#pragma unroll
            for (int i = 0; i < 8; ++i) s += v[i];
            const float mean = wave_sum(s, lane) * (1.0f / 512.0f);
            float q = 0.f;
#pragma unroll
            for (int i = 0; i < 8; ++i) { v[i] -= mean; q += v[i] * v[i]; }
            const float rstd = rsqrtf(wave_sum(q, lane) * (1.0f / 512.0f) + LN_EPS);
            u32x4 w; w.x = pk2(v[0] * rstd, v[1] * rstd); w.y = pk2(v[2] * rstd, v[3] * rstd); w.z = pk2(v[4] * rstd, v[5] * rstd); w.w = pk2(v[6] * rstd, v[7] * rstd);
            *(LAS u32x4*)(c.lds + row * RS + lane * 16) = w;
        }
        __syncthreads();
        const int g = c.wave >> 1, ph = c.wave & 1;
        f32x16 acc[2][4];
#pragma unroll
        for (int mt = 0; mt < 2; ++mt)
#pragma unroll
            for (int ct = 0; ct < 4; ++ct)
#pragma unroll
                for (int i = 0; i < 16; ++i) acc[mt][ct][i] = 0.f;
        for (int ks = 0; ks < 8; ++ks) {
            bf16x8 af[2];
#pragma unroll
            for (int mt = 0; mt < 2; ++mt) af[mt] = *(const bf16x8*)(WS + ((size_t)g * 128 + ph * 64 + mt * 32 + l31) * 128 + ks * 16 + hh * 8);
#pragma unroll
            for (int ct = 0; ct < 4; ++ct) {
                const int q0 = 16 * ks + 8 * hh + (li >> 2), colb = (g * 128 + ct * 32 + 16 * (gg & 1) + 4 * (li & 3)) * 2;
                const s16x4 lo = __builtin_bit_cast(s16x4, __builtin_amdgcn_ds_read_tr16_b64_v4i16((LAS v4i16_t*)(c.lds + q0 * RS + colb)));
                const s16x4 hi = __builtin_bit_cast(s16x4, __builtin_amdgcn_ds_read_tr16_b64_v4i16((LAS v4i16_t*)(c.lds + (q0 + 4) * RS + colb)));
                bf16x8 bfr; bfr[0] = lo[0]; bfr[1] = lo[1]; bfr[2] = lo[2]; bfr[3] = lo[3]; bfr[4] = hi[0]; bfr[5] = hi[1]; bfr[6] = hi[2]; bfr[7] = hi[3];
#pragma unroll
                for (int mt = 0; mt < 2; ++mt) acc[mt][ct] = __builtin_amdgcn_mfma_f32_32x32x16_bf16(bfr, af[mt], acc[mt][ct], 0, 0, 0);
            }
        }
#pragma unroll
        for (int mt = 0; mt < 2; ++mt) {
            const int p = ph * 64 + mt * 32 + l31;
            const float bs = BS[g * 128 + p];
#pragma unroll
            for (int ct = 0; ct < 4; ++ct)
#pragma unroll
                for (int gi = 0; gi < 4; ++gi) {
                    const int col = g * 128 + ct * 32 + 8 * gi + 4 * hh;
                    const u32x2 uu = *(const u32x2*)(P + (tok0 + p) * ABIN + 1536 + col);
                    u32x2 w; w.x = pk2(bf2f(uu.x) * (acc[mt][ct][4 * gi] + bs), bf2f(uu.x >> 16) * (acc[mt][ct][4 * gi + 1] + bs));
                    w.y = pk2(bf2f(uu.y) * (acc[mt][ct][4 * gi + 2] + bs), bf2f(uu.y >> 16) * (acc[mt][ct][4 * gi + 3] + bs));
                    *(u32x2*)(MIXO + (tok0 + p) * D + 512 + col) = w;
                }
        }
    }
    __syncthreads();
}

template <int CM = 0> __device__ __forceinline__ void ln_row(float (&v)[16], const float* g, const float* b, int lane) {
    float s = 0.f;
#pragma unroll
    for (int i = 0; i < 16; ++i) s += v[i];
    const float mean = wave_sum(s, lane) * (1.0f / 1024.0f);
    float q = 0.f;
#pragma unroll
    for (int i = 0; i < 16; ++i) { v[i] -= mean; q += v[i] * v[i]; }
    const float rstd = rsqrtf(wave_sum(q, lane) * (1.0f / 1024.0f) + LN_EPS);
#pragma unroll
    for (int m = 0; m < 4; ++m) { const int col = CM == 3 ? 128 * (4 * (lane >> 5) + m) + 4 * (lane & 31) : (CM == 2 ? 32 * (lane & 31) + 16 * (lane >> 5) + 4 * m : (CM == 1 ? 16 * lane + 4 * m : 256 * m + 4 * lane)); const f32x4 gv = *(const f32x4*)(g + col), bv = *(const f32x4*)(b + col);
#pragma unroll
        for (int e = 0; e < 4; ++e) v[4 * m + e] = v[4 * m + e] * rstd * gv[e] + bv[e]; }
}
template <int CM = 0> __device__ __forceinline__ void store_mod_bf16(const float (&v)[16], bf16_t* dst, const float* sh, const float* sc, int lane) {
#pragma unroll
    for (int m = 0; m < 4; ++m) { const int col = CM == 3 ? 128 * (4 * (lane >> 5) + m) + 4 * (lane & 31) : (CM == 2 ? 32 * (lane & 31) + 16 * (lane >> 5) + 4 * m : (CM == 1 ? 16 * lane + 4 * m : 256 * m + 4 * lane)); const f32x4 s = *(const f32x4*)(sc + col), h = *(const f32x4*)(sh + col);
        u32x2 w; w.x = pk2(v[4 * m] * (1.0f + s[0]) + h[0], v[4 * m + 1] * (1.0f + s[1]) + h[1]); w.y = pk2(v[4 * m + 2] * (1.0f + s[2]) + h[2], v[4 * m + 3] * (1.0f + s[3]) + h[3]);
        *(u32x2*)(dst + col) = w; }
}

__device__ __forceinline__ bf16_t* resid_buf(const Ctx& c, int which) { return which < 2 ? (bf16_t*)c.a->out + (size_t)which * NTOK * D : c.ws<bf16_t>(WS_MIX); }
__device__ void phase_ln1(const Ctx& c, int layer) {
    bf16_t* HQ = c.ws<bf16_t>(WS_HB); const bf16_t* Y = c.ws<bf16_t>(WS_BIG);
    const float* resf = c.in(I_X); const bf16_t* resb = resid_buf(c, 1); bf16_t* XO = resid_buf(c, layer == 0 ? 0 : 2);
    const float* g = c.in(I_LNG) + (layer * 2 + 0) * D; const float* b = c.in(I_LNB) + (layer * 2 + 0) * D;
    for (int row0 = (c.bid * 8 + c.wave) * 2; row0 < NTOK; row0 += c.G * 8 * 2) {
        const float* mod = c.ws<float>(WS_MOD) + (layer * 2 + row0 / SEQ) * 6144;
        float v[2][16];
#pragma unroll
        for (int q = 0; q < 2; ++q)
#pragma unroll
            for (int m = 0; m < 4; ++m) { const int col = 256 * m + 4 * c.lane; const f32x4 g1 = *(const f32x4*)(mod + 2 * 1024 + col);
                f32x4 t;
                if (layer == 0) t = *(const f32x4*)(resf + (size_t)(row0 + q) * D + col);
                else { const u32x2 tb = *(const u32x2*)(resb + (size_t)(row0 + q) * D + col); t = (f32x4){bf2f(tb[0]), bf2f(tb[0] >> 16), bf2f(tb[1]), bf2f(tb[1] >> 16)}; }
                const u32x2 yy = *(const u32x2*)(Y + (size_t)(row0 + q) * D + col);
                v[q][4 * m] = DN_ALPHA * t[0] + g1[0] * bf2f(yy[0]); v[q][4 * m + 1] = DN_ALPHA * t[1] + g1[1] * bf2f(yy[0] >> 16);
                v[q][4 * m + 2] = DN_ALPHA * t[2] + g1[2] * bf2f(yy[1]); v[q][4 * m + 3] = DN_ALPHA * t[3] + g1[3] * bf2f(yy[1] >> 16); }
#pragma unroll
        for (int q = 0; q < 2; ++q) {
            ln_row(v[q], g, b, c.lane);
#pragma unroll
            for (int m = 0; m < 4; ++m) *(u32x2*)(XO + (size_t)(row0 + q) * D + 256 * m + 4 * c.lane) = (u32x2){pk2(v[q][4 * m], v[q][4 * m + 1]), pk2(v[q][4 * m + 2], v[q][4 * m + 3])};
            store_mod_bf16(v[q], HQ + (size_t)(row0 + q) * D, mod + 3 * 1024, mod + 4 * 1024, c.lane);
        }
    }
}

__device__ __forceinline__ void ce_desc(unsigned& a, unsigned& b) { const unsigned hi = a > b ? a : b, lo = a > b ? b : a; a = hi; b = lo; }
__device__ __forceinline__ void sort16_desc(unsigned (&v)[16]) {
#pragma unroll
    for (int k = 2; k <= 16; k <<= 1)
#pragma unroll
        for (int j = k >> 1; j > 0; j >>= 1)
#pragma unroll
            for (int i = 0; i < 16; ++i) { const int l = i ^ j; if (l > i) { if ((i & k) == 0) ce_desc(v[i], v[l]); else ce_desc(v[l], v[i]); } }
}
__device__ __forceinline__ void bitonic_merge16_desc(unsigned (&v)[16]) {
#pragma unroll
    for (int j = 8; j > 0; j >>= 1)
#pragma unroll
        for (int i = 0; i < 16; ++i) { const int l = i ^ j; if (l > i) ce_desc(v[i], v[l]); }
}
__device__ __forceinline__ void merge_top16(unsigned (&L)[16], unsigned (&C)[16]) {
    sort16_desc(C);
#pragma unroll
    for (int i = 0; i < 16; ++i) L[i] = L[i] > C[15 - i] ? L[i] : C[15 - i];
    bitonic_merge16_desc(L);
}
__device__ __forceinline__ unsigned f32_sortable(float f) { const unsigned u = __builtin_bit_cast(unsigned, f); return u ^ ((u >> 31) ? 0xFFFFFFFFu : 0x80000000u); }
__device__ void phase_topk(const Ctx& c) {
    const _Float16* S = c.ws<_Float16>(WS_BIG);
    unsigned short* IDX = c.ws<unsigned short>(WS_IDX);
    float* GATE = c.ws<float>(WS_GATE);
    LAS unsigned char* wl = c.lds + c.wave * 17408;
    LAS unsigned char* ib = c.lds + 139264 + c.tid * 32;
    const int lane = c.lane;
    for (int blk = c.bid; blk < NTOK * 8 / NT; blk += c.G) {
        const int it0 = blk * NT + c.wave * 64;
        float val[2][16];
#pragma unroll
        for (int part = 0; part < 2; ++part) {
#pragma unroll
            for (int i = 0; i < 16; ++i) { const int row = i * 4 + (lane >> 4), ch = lane & 15, item = it0 + row;
                const u32x4 v = *(const u32x4*)(S + (size_t)(item >> 3) * PQN + (item & 7) * 256 + part * 128 + ch * 8);
                *(LAS u32x4*)(wl + row * 272 + ch * 16) = v; }
            unsigned L[16];
#pragma unroll 1
            for (int q = 0; q < 8; ++q) {
                const u32x4 w0 = *(const LAS u32x4*)(wl + lane * 272 + q * 32), w1 = *(const LAS u32x4*)(wl + lane * 272 + q * 32 + 16);
                const unsigned w[8] = {w0.x, w0.y, w0.z, w0.w, w1.x, w1.y, w1.z, w1.w};
                unsigned C[16];
#pragma unroll
                for (int e = 0; e < 16; ++e) { const unsigned hb = (e & 1) ? (w[e >> 1] >> 16) : (w[e >> 1] & 0xffffu);
                    const unsigned sk = hb ^ ((hb & 0x8000u) ? 0xffffu : 0x8000u);
                    C[e] = (sk << 16) | (unsigned)(127 - (q * 16 + e)); }
                if (q == 0) {
#pragma unroll
                    for (int e = 0; e < 16; ++e) L[e] = 0u; }
                merge_top16(L, C);
            }
#pragma unroll
            for (int e = 0; e < 16; ++e) { const unsigned sk = L[e] >> 16, hb = sk ^ ((sk & 0x8000u) ? 0x8000u : 0xffffu);
                val[part][e] = (float)__builtin_bit_cast(_Float16, (unsigned short)hb);
                ib[part * 16 + e] = (unsigned char)(127u - (L[e] & 127u)); }
        }
        unsigned T[16];
#pragma unroll
        for (int j = 0; j < 16; ++j) T[j] = (f32_sortable(val[0][0] + val[1][j]) & 0xffffff00u) | (unsigned)(255 - j);
        {
            unsigned C[16]; int n = 0;
#pragma unroll
            for (int i = 1; i < 16; ++i)
#pragma unroll
                for (int j = 0; j < 16; ++j) if ((i + 1) * (j + 1) <= 16) {
                    const unsigned key = (f32_sortable(val[0][i] + val[1][j]) & 0xffffff00u) | (unsigned)(255 - (16 * i + j));
                    if (n < 32) { C[n & 15] = key; if ((n & 15) == 15) merge_top16(T, C); }
                    else { unsigned x = key;
#pragma unroll
                        for (int k = 0; k < 16; ++k) { const unsigned hi = T[k] > x ? T[k] : x; x = T[k] > x ? x : T[k]; T[k] = hi; } }
                    ++n; }
        }
        float gv[16]; int id[16]; float sum = 0.f, mx;
        { const unsigned sk = T[0] & 0xffffff00u; mx = __builtin_bit_cast(float, (sk & 0x80000000u) ? (sk ^ 0x80000000u) : ~sk); }
#pragma unroll
        for (int k = 0; k < 16; ++k) { const unsigned sk = T[k] & 0xffffff00u, flat = 255u - (T[k] & 255u);
            const float v = __builtin_bit_cast(float, (sk & 0x80000000u) ? (sk ^ 0x80000000u) : ~sk);
            gv[k] = __expf(v - mx); sum += gv[k];
            id[k] = (int)ib[flat >> 4] * 128 + (int)ib[16 + (flat & 15)]; }
        const float inv = 1.0f / sum;
        const size_t o = (size_t)(blk * NT + c.tid) * 16;
#pragma unroll
        for (int q = 0; q < 2; ++q) { u32x4 w; w.x = id[8 * q] | (id[8 * q + 1] << 16); w.y = id[8 * q + 2] | (id[8 * q + 3] << 16); w.z = id[8 * q + 4] | (id[8 * q + 5] << 16); w.w = id[8 * q + 6] | (id[8 * q + 7] << 16);
            *(u32x4*)(IDX + o + 8 * q) = w; }
#pragma unroll
        for (int q = 0; q < 4; ++q) *(f32x4*)(GATE + o + 4 * q) = (f32x4){gv[4 * q] * inv, gv[4 * q + 1] * inv, gv[4 * q + 2] * inv, gv[4 * q + 3] * inv};
    }
}

typedef float v32f __attribute__((ext_vector_type(32)));
typedef unsigned v6u_t __attribute__((ext_vector_type(6)));
typedef unsigned u32x4a8 __attribute__((ext_vector_type(4), aligned(8)));
typedef _Float16 v32h_t __attribute__((ext_vector_type(32)));
typedef _Float16 v2h_t __attribute__((ext_vector_type(2)));
constexpr int NSL = 2;
__device__ void phase_gather_u(const Ctx& c, int layer) {
    const bf16_t* HQ = c.ws<bf16_t>(WS_HB);
    const unsigned short* IDX = c.ws<unsigned short>(WS_IDX);
    float* PART = c.ws<float>(WS_BIG);
    const int lane = c.lane, r16 = lane & 15, g = lane >> 4;
    const int h = (c.bid & 7) >> 2, r = 16 * h + r16;
    const unsigned char* U6 = c.ws<unsigned char>(WS_TAB8) + (size_t)(layer * 2 + 0) * 16384 * 768 + 24 * r;
    const bool b3 = lane & 8, b2 = lane & 4, b1 = lane & 2;
    const int jmine = 4 * (int)b3 + 2 * (int)b2 + (int)b1;
    const int nblk = c.G >> 1, blk = (c.bid >> 3) * 4 + (c.bid & 3);
    const int tstep = nblk * 8;
#define GU_LOAD_TOK(t_, hq_, i0_, i1_) do { const int t__ = (t_) < NTOK ? (t_) : NTOK - 1; \
        _Pragma("unroll") for (int m = 0; m < 8; ++m) hq_[m] = *(const u32x2*)(HQ + (size_t)t__ * D + 128 * m + 4 * r); \
        i0_ = IDX[(size_t)t__ * 128 + lane]; i1_ = IDX[(size_t)t__ * 128 + 64 + lane]; } while (0)
#define GU_ISSUE(i0_, i1_, ch_, a4_, a2_) do { _Pragma("unroll") for (int j = 0; j < 8; ++j) { const int id = lane_geti((ch_) < 2 ? i0_ : i1_, (32 * (ch_) + 4 * j + g) & 63); const unsigned char* up = U6 + __umul24((unsigned)id, 768u); \
        a4_[j] = *(const u32x4a8*)up; a2_[j] = *(const u32x2*)(up + 16); } } while (0)
#define GU_COMPUTE(a4_, a2_, ch_, t_) do { float p[8]; \
        _Pragma("unroll") for (int j = 0; j < 8; ++j) { const v6u_t q = {a4_[j][0], a4_[j][1], a4_[j][2], a4_[j][3], a2_[j][0], a2_[j][1]}; \
            const v32h_t f = __builtin_amdgcn_cvt_scalef32_pk32_f16_fp6(q, 1.0f); float sdot = 0.f;     \
            _Pragma("unroll") for (int i = 0; i < 16; ++i) sdot = __builtin_amdgcn_fdot2((v2h_t){f[2 * i], f[2 * i + 1]}, xh[i], sdot, false); \
            p[j] = sdot; __builtin_amdgcn_sched_barrier(0); } \
        float r2[4], r3[2], r4;     \
        _Pragma("unroll") for (int k = 0; k < 4; ++k) { const float send = b3 ? p[k] : p[k + 4], keep = b3 ? p[k + 4] : p[k]; r2[k] = keep + dppx<0x128>(send); }     \
        _Pragma("unroll") for (int k = 0; k < 2; ++k) { const float send = b2 ? r2[k] : r2[k + 2], keep = b2 ? r2[k + 2] : r2[k]; r3[k] = keep + dppx<0x141>(send); }     \
        { const float send = b1 ? r3[0] : r3[1], keep = b1 ? r3[1] : r3[0]; r4 = keep + dppx<0x4E>(send); }     \
        r4 += dppx<0xB1>(r4);     \
        if ((t_) < NTOK && (lane & 1) == 0) PART[((size_t)(t_) * NSL + h) * 128 + 32 * (ch_) + 4 * jmine + g] = r4; } while (0)
    int tok = blk * 8 + c.wave;
    u32x2 hqc[8], hqn[8]; int ic0, ic1, in0, in1;
    u32x4 ra4[8], rb4[8]; u32x2 ra2[8], rb2[8];
    GU_LOAD_TOK(tok, hqc, ic0, ic1);
    GU_ISSUE(ic0, ic1, 0, ra4, ra2);
#pragma unroll 1
    for (; tok < NTOK; tok += tstep) {
        v2h_t xh[16];
#pragma unroll
        for (int m = 0; m < 8; ++m)
#pragma unroll
            for (int e = 0; e < 2; ++e) xh[2 * m + e] = __builtin_bit_cast(v2h_t, __builtin_amdgcn_cvt_pkrtz(bf2f(hqc[m][e]), bf2f(hqc[m][e] >> 16)));
        GU_LOAD_TOK(tok + tstep, hqn, in0, in1);
        GU_ISSUE(ic0, ic1, 1, rb4, rb2); GU_COMPUTE(ra4, ra2, 0, tok);
        GU_ISSUE(ic0, ic1, 2, ra4, ra2); GU_COMPUTE(rb4, rb2, 1, tok);
        GU_ISSUE(ic0, ic1, 3, rb4, rb2); GU_COMPUTE(ra4, ra2, 2, tok);
        GU_ISSUE(in0, in1, 0, ra4, ra2); GU_COMPUTE(rb4, rb2, 3, tok);
#pragma unroll
        for (int m = 0; m < 8; ++m) hqc[m] = hqn[m];
        ic0 = in0; ic1 = in1;
    }
#undef GU_LOAD_TOK
#undef GU_ISSUE
#undef GU_COMPUTE
}
__device__ void phase_gather_v(const Ctx& c, int layer) {
    float* X = c.a->out; const bf16_t* XI = resid_buf(c, layer == 0 ? 0 : 2); bf16_t* XO = resid_buf(c, 1);
    const unsigned short* IDX = c.ws<unsigned short>(WS_IDX);
    const float* GATE = c.ws<float>(WS_GATE); const float* PART = c.ws<float>(WS_BIG);
    const f32x2* DQ2 = c.ws<f32x2>(WS_DQ) + (size_t)layer * 16384;
    const unsigned char* V6 = c.ws<unsigned char>(WS_TAB8) + (size_t)(layer * 2 + 1) * 16384 * 768;
    const float* g = c.in(I_LNG) + (layer * 2 + 1) * D; const float* b = c.in(I_LNB) + (layer * 2 + 1) * D;
    const int lane = c.lane, hh = lane >> 5, r = lane & 31;
    const unsigned char* V6r = V6 + 24 * r;
    const int tstep = c.G * 8;
#define GV_ISSUE(isel_, wsel_, ch_, a4_, a2_, wj_) do { _Pragma("unroll") for (int j = 0; j < 4; ++j) { const int sl_ = (8 * (ch_) + 2 * j + hh) & 63; const int id = lane_geti(isel_, sl_); \
        { const float wf_ = lane_get(wsel_, sl_); wj_[j] = __builtin_bit_cast(v2h_t, __builtin_amdgcn_cvt_pkrtz(wf_, wf_)); } \
        const unsigned char* vp = V6r + __umul24((unsigned)id, 768u); a4_[j] = *(const u32x4a8*)vp; a2_[j] = *(const u32x2*)(vp + 16); } } while (0)
#define GV_COMPUTE(a4_, a2_, wj_) do { _Pragma("unroll") for (int j = 0; j < 4; ++j) { const v6u_t wv = {a4_[j][0], a4_[j][1], a4_[j][2], a4_[j][3], a2_[j][0], a2_[j][1]}; \
        const v32h_t f = __builtin_amdgcn_cvt_scalef32_pk32_f16_fp6(wv, 1.0f);     \
        _Pragma("unroll") for (int i = 0; i < 16; ++i) acc2[i] = __builtin_elementwise_fma((v2h_t){f[2 * i], f[2 * i + 1]}, wj_[j], acc2[i]);     \
        __builtin_amdgcn_sched_barrier(0); } } while (0)
#define GV_PAIR(cp_) do { { const int ch_ = 2 * (cp_) + 1; GV_ISSUE((ch_ < 8 ? id0 : id1), (ch_ < 8 ? w0 : w1), ch_, rb4, rb2, wb); } \
        GV_COMPUTE(ra4, ra2, wa); \
        { const int ch_ = (2 * (cp_) + 2) & 15; const bool nx_ = (cp_) == 7; GV_ISSUE((nx_ ? idn0 : (ch_ < 8 ? id0 : id1)), (nx_ ? wn0 : (ch_ < 8 ? w0 : w1)), ch_, ra4, ra2, wa); } \
        GV_COMPUTE(rb4, rb2, wb); } while (0)
#define GV_WEIGHTS(t_, i0_, i1_, o0_, o1_) do { const f32x2 dq0 = DQ2[i0_], dq1 = DQ2[i1_]; const float g0 = GATE[(size_t)(t_) * 128 + lane], g1 = GATE[(size_t)(t_) * 128 + 64 + lane]; \
        float s0 = 0.f, s1 = 0.f; \
        _Pragma("unroll") for (int sl = 0; sl < NSL; ++sl) { s0 += PART[((size_t)(t_) * NSL + sl) * 128 + lane]; s1 += PART[((size_t)(t_) * NSL + sl) * 128 + 64 + lane]; } \
        o0_ = gelu_erf(s0 * dq0[0]) * (g0 * dq0[1]); o1_ = gelu_erf(s1 * dq1[0]) * (g1 * dq1[1]); } while (0)
#define GV_NORM(o0_, o1_, mx_) do { mx_ = wave_max(fmaxf(fabsf(o0_), fabsf(o1_)), lane); const float inv_ = mx_ > 0.f ? 1.0f / mx_ : 0.f; o0_ *= inv_; o1_ *= inv_; } while (0)
    int tok = c.bid * 8 + c.wave;
    int id0 = 0, id1 = 0, idn0, idn1; float w0 = 0.f, w1 = 0.f, wn0, wn1;
    u32x4 ra4[4], rb4[4]; u32x2 ra2[4], rb2[4]; v2h_t wa[4], wb[4]; float wmax = 0.f, wmaxn;
    if (tok < NTOK) { id0 = IDX[(size_t)tok * 128 + lane]; id1 = IDX[(size_t)tok * 128 + 64 + lane]; GV_WEIGHTS(tok, id0, id1, w0, w1); GV_NORM(w0, w1, wmax); }
    GV_ISSUE(id0, w0, 0, ra4, ra2, wa);
#pragma unroll 1
    for (; tok < NTOK; tok += tstep) {
        const int bt = tok / SEQ;
        const float* mod = c.ws<float>(WS_MOD) + (layer * 2 + bt) * 6144;
        const int tn = tok + tstep < NTOK ? tok + tstep : tok;
        v2h_t acc2[16];
#pragma unroll
        for (int i = 0; i < 16; ++i) acc2[i] = (v2h_t){(_Float16)0.f, (_Float16)0.f};
        idn0 = IDX[(size_t)tn * 128 + lane]; idn1 = IDX[(size_t)tn * 128 + 64 + lane];
        const float gn0 = GATE[(size_t)tn * 128 + lane], gn1 = GATE[(size_t)tn * 128 + 64 + lane];
        float sn0 = 0.f, sn1 = 0.f; float pn[2 * NSL];
#pragma unroll
        for (int sl = 0; sl < NSL; ++sl) { pn[2 * sl] = PART[((size_t)tn * NSL + sl) * 128 + lane]; pn[2 * sl + 1] = PART[((size_t)tn * NSL + sl) * 128 + 64 + lane]; }
#pragma unroll 1
        for (int cp = 0; cp < 2; ++cp) GV_PAIR(cp);
        const f32x2 dqn0 = DQ2[idn0], dqn1 = DQ2[idn1];
#pragma unroll 1
        for (int cp = 2; cp < 6; ++cp) GV_PAIR(cp);
#pragma unroll
        for (int sl = 0; sl < NSL; ++sl) { sn0 += pn[2 * sl]; sn1 += pn[2 * sl + 1]; }
        wn0 = gelu_erf(sn0 * dqn0[0]) * (gn0 * dqn0[1]); wn1 = gelu_erf(sn1 * dqn1[0]) * (gn1 * dqn1[1]); GV_NORM(wn0, wn1, wmaxn);
        f32x4 x1v[4], g2v[4];
#pragma unroll
        for (int m = 0; m < 4; ++m) { const int col = 128 * (4 * hh + m) + 4 * r; { const u32x2 tb = *(const u32x2*)(XI + (size_t)tok * D + col); x1v[m] = (f32x4){bf2f(tb[0]), bf2f(tb[0] >> 16), bf2f(tb[1]), bf2f(tb[1] >> 16)}; } g2v[m] = *(const f32x4*)(mod + 5 * 1024 + col); }
#pragma unroll 1
        for (int cp = 6; cp < 8; ++cp) GV_PAIR(cp);
        float y[16];
#pragma unroll
        for (int k = 0; k < 8; ++k) { const v2h_t send = hh ? acc2[k] : acc2[8 + k], keep = hh ? acc2[8 + k] : acc2[k];
            const v2h_t got = __builtin_bit_cast(v2h_t, lane_geti(__builtin_bit_cast(int, send), lane ^ 32));
            y[2 * k] = ((float)keep[0] + (float)got[0]) * wmax; y[2 * k + 1] = ((float)keep[1] + (float)got[1]) * wmax; }
#pragma unroll
        for (int m = 0; m < 4; ++m) { const f32x4 g2 = g2v[m], x1 = x1v[m];
#pragma unroll
            for (int e = 0; e < 4; ++e) y[4 * m + e] = DN_ALPHA * x1[e] + g2[e] * y[4 * m + e]; }
        ln_row<3>(y, g, b, lane);
        if (layer == 0) {
#pragma unroll
            for (int m = 0; m < 4; ++m) *(u32x2*)(XO + (size_t)tok * D + 128 * (4 * hh + m) + 4 * r) = (u32x2){pk2(y[4 * m], y[4 * m + 1]), pk2(y[4 * m + 2], y[4 * m + 3])};
        } else {
#pragma unroll
            for (int m = 0; m < 4; ++m) *(f32x4*)(X + (size_t)tok * D + 128 * (4 * hh + m) + 4 * r) = (f32x4){y[4 * m], y[4 * m + 1], y[4 * m + 2], y[4 * m + 3]};
        }
        if (layer == 0) { const float* mod1 = c.ws<float>(WS_MOD) + (2 + bt) * 6144; store_mod_bf16<3>(y, c.ws<bf16_t>(WS_MIX) + (size_t)tok * D, mod1, mod1 + 1024, lane); }
        id0 = idn0; id1 = idn1; w0 = wn0; w1 = wn1; wmax = wmaxn;
    }
#undef GV_ISSUE
#undef GV_COMPUTE
#undef GV_PAIR
#undef GV_WEIGHTS
#undef GV_NORM
}

typedef _Float16 cf __attribute__((ext_vector_type(2)));
struct cs { float x, y; };
__device__ __forceinline__ cs smul(cs a, cs b) { return cs{a.x * b.x - a.y * b.y, a.x * b.y + a.y * b.x}; }
__device__ __forceinline__ cs smulc(cs a, cs b) { return cs{a.x * b.x + a.y * b.y, a.y * b.x - a.x * b.y}; }
__device__ __forceinline__ unsigned cpack(float re, float im) { unsigned r; asm("v_cvt_pk_f16_f32 %0, %1, %2" : "=v"(r) : "v"(re), "v"(im)); return r; }
__device__ __forceinline__ cs cunpack(unsigned v) { const cf h = __builtin_bit_cast(cf, v); return cs{(float)h[0], (float)h[1]}; }
__device__ __forceinline__ cf cmul(cf a, cf b) { const cf t = __builtin_shufflevector(a, a, 1, 1) * __builtin_shufflevector(b, b, 1, 0);
    return __builtin_elementwise_fma(__builtin_shufflevector(a, a, 0, 0), b, __builtin_shufflevector(-t, t, 0, 3)); }
__device__ __forceinline__ cf cmulc(cf a, cf b) { const cf t = __builtin_shufflevector(a, a, 1, 0) * __builtin_shufflevector(b, b, 1, 1);
    return __builtin_elementwise_fma(a, __builtin_shufflevector(b, b, 0, 0), __builtin_shufflevector(t, -t, 0, 3)); }
__device__ __forceinline__ cf cmul_k(cf a, cf b) { return cmul(a, b); }
__device__ __forceinline__ cf cmulc_k(cf a, cf b) { return cmulc(a, b); }
__device__ __forceinline__ cf cscale(cf a, cf s2) { return a * s2; }
__device__ __forceinline__ cf cadd(cf a, cf b) { return a + b; }
__device__ __forceinline__ cf csub(cf a, cf b) { return a - b; }
__device__ __forceinline__ cf cadd_mi(cf a, cf b) { return a + __builtin_shufflevector(b, -b, 1, 2); }
__device__ __forceinline__ cf cadd_pi(cf a, cf b) { return a + __builtin_shufflevector(-b, b, 1, 2); }
template <bool INV> __device__ __forceinline__ void dft4(cf& a0, cf& a1, cf& a2, cf& a3) {
    const cf s02 = cadd(a0, a2), d02 = csub(a0, a2), s13 = cadd(a1, a3), d13 = csub(a1, a3);
    a0 = cadd(s02, s13); a2 = csub(s02, s13);
    a1 = INV ? cadd_pi(d02, d13) : cadd_mi(d02, d13); a3 = INV ? cadd_mi(d02, d13) : cadd_pi(d02, d13);
}
__device__ __forceinline__ cf cconst(float re, float im) { return (cf){(_Float16)re, (_Float16)im}; }
template <bool INV> __device__ __forceinline__ cf w16(cf a, int m) {
    const float c1 = 0.92387953251128674f, s1 = 0.38268343236508977f, r = 0.70710678118654752f;
    cf w;
    switch (m) { case 0: return a; case 1: w = cconst(c1, -s1); break; case 2: w = cconst(r, -r); break; case 3: w = cconst(s1, -c1); break; case 4: w = cconst(0.f, -1.f); break; case 6: w = cconst(-r, -r); break; default: w = cconst(-c1, s1); break; }
    return INV ? cmulc_k(a, w) : cmul_k(a, w);
}
template <bool INV> __device__ __forceinline__ void dft16(cf (&v)[16]) {
#pragma unroll
    for (int b = 0; b < 4; ++b) dft4<INV>(v[b], v[4 + b], v[8 + b], v[12 + b]);
#pragma unroll
    for (int k1 = 1; k1 < 4; ++k1)
#pragma unroll
        for (int b = 1; b < 4; ++b) v[4 * k1 + b] = w16<INV>(v[4 * k1 + b], b * k1);
#pragma unroll
    for (int k1 = 0; k1 < 4; ++k1) dft4<INV>(v[4 * k1], v[4 * k1 + 1], v[4 * k1 + 2], v[4 * k1 + 3]);
}
__device__ __forceinline__ int fpad(int p) { return p + ((p >> 6) << 2); }
typedef LAS cf* cbuf_t;
__device__ __forceinline__ cf ldc(cbuf_t b, int i) { return b[i]; }
__device__ __forceinline__ void stc(cbuf_t b, int i, cf v) { b[i] = v; }
__device__ __forceinline__ void wpowers(cf w, cf (&p)[16]) {
    p[1] = w; p[2] = cmul(w, w); p[3] = cmul(p[2], w); p[4] = cmul(p[2], p[2]); p[5] = cmul(p[4], w); p[6] = cmul(p[3], p[3]); p[7] = cmul(p[4], p[3]);
    p[8] = cmul(p[4], p[4]); p[9] = cmul(p[8], w); p[10] = cmul(p[5], p[5]); p[11] = cmul(p[8], p[3]); p[12] = cmul(p[6], p[6]); p[13] = cmul(p[8], p[5]); p[14] = cmul(p[7], p[7]); p[15] = cmul(p[8], p[7]);
}
template <bool INV> __device__ __forceinline__ void fft_stage16(cbuf_t buf, int base, int s, cf w) {
    cf v[16], p[16];
#pragma unroll
    for (int j = 0; j < 16; ++j) v[j] = ldc(buf, fpad(base + j * s));
    wpowers(w, p);
    if (INV) {
#pragma unroll
        for (int k = 1; k < 16; ++k) v[k] = cmulc(v[k], p[k]);
    }
    dft16<INV>(v);
    if (!INV) {
#pragma unroll
        for (int k = 1; k < 16; ++k) { const int r = 4 * (k & 3) + (k >> 2); v[r] = cmul(v[r], p[k]); }
    }
#pragma unroll
    for (int k = 0; k < 16; ++k) stc(buf, fpad(base + k * s), v[4 * (k & 3) + (k >> 2)]);
}
__device__ __forceinline__ cf ldtw(const f32x2* t, int i) { const f32x2 v = t[i]; return __builtin_bit_cast(cf, cpack(v[0], v[1])); }

__device__ __forceinline__ void fft_fwd_to_regs(cbuf_t buf, int tid, const f32x2* tws, unsigned (&K)[32], float sc) {
#pragma unroll
    for (int rep = 0; rep < 2; ++rep) { const int id = tid + NT * rep; fft_stage16<false>(buf, id, 1024, ldtw(tws, id)); }
    __syncthreads();
#pragma unroll
    for (int rep = 0; rep < 2; ++rep) { const int id = tid + NT * rep; fft_stage16<false>(buf, (id >> 6) * 1024 + (id & 63), 64, ldtw(tws + 1024, id & 63)); }
    __syncthreads();
#pragma unroll
    for (int rep = 0; rep < 2; ++rep) { const int id = tid + NT * rep; fft_stage16<false>(buf, (id >> 2) * 64 + (id & 3), 4, ldtw(tws + 1088, id & 3)); }
    __syncthreads();
    const cf scv = __builtin_bit_cast(cf, cpack(sc, sc));
#pragma unroll
    for (int rep = 0; rep < 8; ++rep) { const int base = fpad(4 * (tid + NT * rep));
        cf a0 = ldc(buf, base), a1 = ldc(buf, base + 1), a2 = ldc(buf, base + 2), a3 = ldc(buf, base + 3);
        dft4<false>(a0, a1, a2, a3);
        K[4 * rep] = __builtin_bit_cast(unsigned, cscale(a0, scv)); K[4 * rep + 1] = __builtin_bit_cast(unsigned, cscale(a1, scv)); K[4 * rep + 2] = __builtin_bit_cast(unsigned, cscale(a2, scv)); K[4 * rep + 3] = __builtin_bit_cast(unsigned, cscale(a3, scv)); }
    __syncthreads();
}
__device__ __forceinline__ void fft_conv_with_regs(cbuf_t buf, int tid, const f32x2* tws, const unsigned (&K)[32]) {
#pragma unroll
    for (int rep = 0; rep < 2; ++rep) { const int id = tid + NT * rep; fft_stage16<false>(buf, id, 1024, ldtw(tws, id)); }
    __syncthreads();
#pragma unroll
    for (int rep = 0; rep < 2; ++rep) { const int id = tid + NT * rep; fft_stage16<false>(buf, (id >> 6) * 1024 + (id & 63), 64, ldtw(tws + 1024, id & 63)); }
    __syncthreads();
#pragma unroll
    for (int rep = 0; rep < 2; ++rep) { const int id = tid + NT * rep; fft_stage16<false>(buf, (id >> 2) * 64 + (id & 3), 4, ldtw(tws + 1088, id & 3)); }
    __syncthreads();
#pragma unroll
    for (int rep = 0; rep < 8; ++rep) { const int base = fpad(4 * (tid + NT * rep));
        cf a0 = ldc(buf, base), a1 = ldc(buf, base + 1), a2 = ldc(buf, base + 2), a3 = ldc(buf, base + 3);
        dft4<false>(a0, a1, a2, a3);
        a0 = cmul(a0, __builtin_bit_cast(cf, K[4 * rep])); a1 = cmul(a1, __builtin_bit_cast(cf, K[4 * rep + 1])); a2 = cmul(a2, __builtin_bit_cast(cf, K[4 * rep + 2])); a3 = cmul(a3, __builtin_bit_cast(cf, K[4 * rep + 3]));
        dft4<true>(a0, a1, a2, a3);
        stc(buf, base, a0); stc(buf, base + 1, a1); stc(buf, base + 2, a2); stc(buf, base + 3, a3); }
    __syncthreads();
#pragma unroll
    for (int rep = 0; rep < 2; ++rep) { const int id = tid + NT * rep; fft_stage16<true>(buf, (id >> 2) * 64 + (id & 3), 4, ldtw(tws + 1088, id & 3)); }
    __syncthreads();
#pragma unroll
    for (int rep = 0; rep < 2; ++rep) { const int id = tid + NT * rep; fft_stage16<true>(buf, (id >> 6) * 1024 + (id & 63), 64, ldtw(tws + 1024, id & 63)); }
    __syncthreads();
#pragma unroll
    for (int rep = 0; rep < 2; ++rep) { const int id = tid + NT * rep; fft_stage16<true>(buf, id, 1024, ldtw(tws, id)); }
    __syncthreads();
}

__device__ __forceinline__ void sconv8(const bf16_t* row, int t0, float w0, float w1, float w2, float cb, float (&o)[8]) {
    const u32x4 m = *(const u32x4*)(row + t0);
    const unsigned lraw = *(const unsigned*)(row + (t0 > 0 ? t0 - 2 : 0));
    const unsigned rraw = *(const unsigned*)(row + (t0 + 8 < SEQ ? t0 + 8 : SEQ - 2));
    const unsigned l = t0 > 0 ? lraw : 0u, r = t0 + 8 < SEQ ? rraw : 0u;
    float x[10];
    x[0] = bf2f(l >> 16); x[9] = bf2f(r);
#pragma unroll
    for (int k = 0; k < 4; ++k) { x[1 + 2 * k] = bf2f(m[k]); x[2 + 2 * k] = bf2f(m[k] >> 16); }
#pragma unroll
    for (int k = 0; k < 8; ++k) o[k] = w0 * x[k] + w1 * x[k + 1] + w2 * x[k + 2] + cb;
}
__device__ __forceinline__ void unpack8(const u32x4 m, float (&x)[8]) {
#pragma unroll
    for (int k = 0; k < 4; ++k) { x[2 * k] = bf2f(m[k]); x[2 * k + 1] = bf2f(m[k] >> 16); }
}
__device__ void phase_hyena_conv(const Ctx& c) {
    cbuf_t buf = (cbuf_t)c.lds;
    LAS float* red = (LAS float*)(c.lds + 139264);
    const bf16_t* ZT = c.ws<bf16_t>(WS_BIG);
    bf16_t* YT = c.ws<bf16_t>(WS_MIX);
    const bf16_t* FILT = c.ws<bf16_t>(WS_FILT);
    const f32x2* tws = c.ws<f32x2>(WS_TWS);
    const f32x2* twodd = c.ws<f32x2>(WS_TWODD);
    unsigned* scr_vv = c.ws<unsigned>(WS_HB) + (size_t)c.bid * 2 * SEQ;
    unsigned* scr_re = scr_vv + SEQ;
    const float* CW = c.in(I_HYCW); const float* CB = c.in(I_HYCB);
    const int tid = c.tid;
    const int rot = c.bid & 3;
    constexpr float FS = 1.0f / 16.0f, ZS = 1.0f / 256.0f;
    LAS unsigned* twl = (LAS unsigned*)(c.lds + 69632);
    __syncthreads();
    for (int e = tid; e < SEQ; e += NT) { const f32x2 w = twodd[e]; twl[e] = cpack(w[0], w[1]); }
#define TWL8(t0, wa, wb) const u32x4 wa = *(const LAS u32x4*)(twl + (t0)), wb = *(const LAS u32x4*)(twl + (t0) + 4)
#define TWJ(wa, wb, j) cunpack((j) < 4 ? wa[(j) & 3] : wb[(j) & 3])
#define T8(m) (8 * (tid + NT * (((m) + rot) & 3)))
#define LDSQ(t0, k) (*(LAS u32x2*)((LAS unsigned*)buf + fpad((t0) + 2 * (k))))
    for (int ch = c.bid; ch < 1024; ch += c.G) {
        const bf16_t* fw = FILT + (size_t)ch * SEQ; const bf16_t* bw = FILT + (size_t)(1024 + ch) * SEQ;
        unsigned K[32];
        __syncthreads();
        float l1p = 0.f;
#pragma unroll
        for (int m = 0; m < 4; ++m) { const int t0 = T8(m); float f[8], b[8]; unpack8(*(const u32x4*)(fw + t0), f); unpack8(*(const u32x4*)(bw + t0), b);
#pragma unroll
            for (int k = 0; k < 4; ++k) { l1p += (fabsf(f[2 * k]) + fabsf(b[2 * k])) + (fabsf(f[2 * k + 1]) + fabsf(b[2 * k + 1])); LDSQ(t0, k) = (u32x2){cpack((f[2 * k] + b[2 * k]) * FS, 0.f), cpack((f[2 * k + 1] + b[2 * k + 1]) * FS, 0.f)}; } }
        l1p = wave_sum(l1p, c.lane);
        if (c.lane == 0) red[c.wave] = l1p;
        __syncthreads();
        float l1 = 0.f;
#pragma unroll
        for (int w = 0; w < 8; ++w) l1 += red[w];
        const float il1 = 1.0f / l1, ksc = il1 * (1.0f / FS);
        fft_fwd_to_regs(buf, tid, tws, K, ksc);
        {
            const float wx0 = CW[0 * HY3 + 1024 + ch], wx1 = CW[1 * HY3 + 1024 + ch], wx2 = CW[2 * HY3 + 1024 + ch], cbx = CB[1024 + ch];
            const float wv0 = CW[0 * HY3 + 2048 + ch], wv1 = CW[1 * HY3 + 2048 + ch], wv2 = CW[2 * HY3 + 2048 + ch], cbv = CB[2048 + ch];
            const bf16_t* x1r = ZT + (size_t)(1024 + ch) * NTOK; const bf16_t* vr = ZT + (size_t)(2048 + ch) * NTOK;
#pragma unroll 2
            for (int m = 0; m < 4; ++m) { const int t0 = T8(m);
                float va[8], xa[8], vb[8], xb[8];
                sconv8(vr, t0, wv0, wv1, wv2, cbv, va); sconv8(x1r, t0, wx0, wx1, wx2, cbx, xa);
                sconv8(vr + SEQ, t0, wv0, wv1, wv2, cbv, vb); sconv8(x1r + SEQ, t0, wx0, wx1, wx2, cbx, xb);
                u32x4 pv[2];
#pragma unroll
                for (int k = 0; k < 4; ++k) { const f32x4 z = (f32x4){va[2 * k] * xa[2 * k], vb[2 * k] * xb[2 * k], va[2 * k + 1] * xa[2 * k + 1], vb[2 * k + 1] * xb[2 * k + 1]};
                    pv[k >> 1][2 * (k & 1)] = pk2(z[0], z[1]); pv[k >> 1][2 * (k & 1) + 1] = pk2(z[2], z[3]); LDSQ(t0, k) = (u32x2){cpack(z[0] * ZS, z[1] * ZS), cpack(z[2] * ZS, z[3] * ZS)}; }
                *(u32x4*)(scr_vv + t0) = pv[0]; *(u32x4*)(scr_vv + t0 + 4) = pv[1]; }
        }
        __syncthreads();
        fft_conv_with_regs(buf, tid, tws, K);
#pragma unroll 2
        for (int m = 0; m < 4; ++m) { const int t0 = T8(m); float f[8], b[8]; unpack8(*(const u32x4*)(fw + t0), f); unpack8(*(const u32x4*)(bw + t0), b);
            u32x4 pr[2]; TWL8(t0, twa, twb);
#pragma unroll
            for (int k = 0; k < 4; ++k) { const cs w0_ = TWJ(twa, twb, 2 * k), w1_ = TWJ(twa, twb, 2 * k + 1); const f32x4 w = (f32x4){w0_.x, w0_.y, w1_.x, w1_.y};
                { const u32x2 rq = LDSQ(t0, k); const cs r0 = cunpack(rq[0]), r1 = cunpack(rq[1]); pr[k >> 1][2 * (k & 1)] = pk2(r0.x, r0.y); pr[k >> 1][2 * (k & 1) + 1] = pk2(r1.x, r1.y); }
                const float d0 = (f[2 * k] - b[2 * k]) * FS, d1 = (f[2 * k + 1] - b[2 * k + 1]) * FS;
                LDSQ(t0, k) = (u32x2){cpack(d0 * w[0], d0 * w[1]), cpack(d1 * w[2], d1 * w[3])}; }
            *(u32x4*)(scr_re + t0) = pr[0]; *(u32x4*)(scr_re + t0 + 4) = pr[1]; }
        __syncthreads();
        fft_fwd_to_regs(buf, tid, tws, K, ksc);
#pragma unroll 2
        for (int m = 0; m < 4; ++m) { const int t0 = T8(m);
            const u32x4 pv0 = *(const u32x4*)(scr_vv + t0), pv1 = *(const u32x4*)(scr_vv + t0 + 4); TWL8(t0, twa, twb);
#pragma unroll
            for (int k = 0; k < 4; ++k) { const unsigned u0 = k < 2 ? pv0[2 * k] : pv1[2 * k - 4], u1 = k < 2 ? pv0[2 * k + 1] : pv1[2 * k - 3]; const cs w0_ = TWJ(twa, twb, 2 * k), w1_ = TWJ(twa, twb, 2 * k + 1); const f32x4 w = (f32x4){w0_.x, w0_.y, w1_.x, w1_.y};
                const cs a = smul(cs{bf2f(u0) * ZS, bf2f(u0 >> 16) * ZS}, cs{w[0], w[1]}), b = smul(cs{bf2f(u1) * ZS, bf2f(u1 >> 16) * ZS}, cs{w[2], w[3]}); LDSQ(t0, k) = (u32x2){cpack(a.x, a.y), cpack(b.x, b.y)}; } }
        __syncthreads();
        fft_conv_with_regs(buf, tid, tws, K);
        {
            const float w00 = CW[0 * HY3 + ch], w01 = CW[1 * HY3 + ch], w02 = CW[2 * HY3 + ch], cb0 = CB[ch];
            const bf16_t* x0r = ZT + (size_t)ch * NTOK;
            const float dsk = c.in(I_HYD)[ch], scale = 0.5f / 16384.0f / ZS;
#pragma unroll 2
            for (int m = 0; m < 4; ++m) { const int t0 = T8(m);
                float xa[8], xb[8]; sconv8(x0r, t0, w00, w01, w02, cb0, xa); sconv8(x0r + SEQ, t0, w00, w01, w02, cb0, xb);
                u32x4 oa, ob;
                const u32x4 pr0 = *(const u32x4*)(scr_re + t0), pr1 = *(const u32x4*)(scr_re + t0 + 4), pv0 = *(const u32x4*)(scr_vv + t0), pv1 = *(const u32x4*)(scr_vv + t0 + 4); TWL8(t0, twa, twb);
#pragma unroll
                for (int k = 0; k < 4; ++k) { const u32x2 rq = LDSQ(t0, k); const cs ro0 = cunpack(rq[0]), ro1 = cunpack(rq[1]); const cs w0_ = TWJ(twa, twb, 2 * k), w1_ = TWJ(twa, twb, 2 * k + 1); const f32x4 w = (f32x4){w0_.x, w0_.y, w1_.x, w1_.y};
                    const unsigned r0 = k < 2 ? pr0[2 * k] : pr1[2 * k - 4], r1 = k < 2 ? pr0[2 * k + 1] : pr1[2 * k - 3], v0 = k < 2 ? pv0[2 * k] : pv1[2 * k - 4], v1 = k < 2 ? pv0[2 * k + 1] : pv1[2 * k - 3];
                    const f32x4 re = (f32x4){bf2f(r0), bf2f(r0 >> 16), bf2f(r1), bf2f(r1 >> 16)}, vv = (f32x4){bf2f(v0), bf2f(v0 >> 16), bf2f(v1), bf2f(v1 >> 16)};
                    const cs q0 = smulc(ro0, cs{w[0], w[1]}), q1 = smulc(ro1, cs{w[2], w[3]});
                    const float ya0 = ((re[0] + q0.x) * scale + vv[0] * dsk) * xa[2 * k], yb0 = ((re[1] + q0.y) * scale + vv[1] * dsk) * xb[2 * k];
                    const float ya1 = ((re[2] + q1.x) * scale + vv[2] * dsk) * xa[2 * k + 1], yb1 = ((re[3] + q1.y) * scale + vv[3] * dsk) * xb[2 * k + 1];
                    oa[k] = pk2(ya0, ya1); ob[k] = pk2(yb0, yb1); }
                *(u32x4*)(YT + (size_t)ch * NTOK + t0) = oa; *(u32x4*)(YT + (size_t)ch * NTOK + SEQ + t0) = ob; }
        }
    }
#undef LDSQ
#undef T8
#undef TWL8
#undef TWJ
    __syncthreads();
}

__device__ void phase_transpose_y(const Ctx& c) {
    const bf16_t* YT = c.ws<bf16_t>(WS_MIX); bf16_t* Y = c.ws<bf16_t>(WS_HB);
    LAS bf16_t* t = (LAS bf16_t*)c.lds;
    for (int tile = c.bid; tile < 16 * 512; tile += c.G) {
        const int c0 = (tile & 15) * 64, n0 = (tile >> 4) * 64;
        __syncthreads();
        { const int r = c.tid >> 3, q = c.tid & 7; const u32x4 v = *(const u32x4*)(YT + (size_t)(c0 + r) * NTOK + n0 + q * 8);
          const unsigned w[4] = {v.x, v.y, v.z, v.w};
#pragma unroll
          for (int e = 0; e < 8; ++e) t[(q * 8 + e) * 72 + r] = (bf16_t)((w[e >> 1] >> (16 * (e & 1))) & 0xffffu); }
        __syncthreads();
        { const int n = c.tid >> 3, q = c.tid & 7; *(u32x4*)(Y + (size_t)(n0 + n) * D + c0 + q * 8) = *(const LAS u32x4*)(t + n * 72 + q * 8); }
    }
    __syncthreads();
}

#define XB_TMO      128
#define XB_XCNT(j)  (256  + 64 * (j))
#define XB_XSUB(j)  (1280 + 64 * (j))
#define XB_XGEN(j)  (2304 + 64 * (j))
#define XB_TOP      3328
#define XB_TOPGEN   3392
#define XCD_BAR_WORDS 3456
#define XB_SPIN_CAP (1u << 18)
__device__ __forceinline__ unsigned xb_ld(unsigned* p)              { return __hip_atomic_load(p, __ATOMIC_RELAXED, __HIP_MEMORY_SCOPE_AGENT); }
__device__ __forceinline__ unsigned xb_add(unsigned* p, unsigned v) { return __hip_atomic_fetch_add(p, v, __ATOMIC_RELAXED, __HIP_MEMORY_SCOPE_AGENT); }
__device__ __forceinline__ unsigned xb_xcc_id() { return (unsigned)__builtin_amdgcn_s_getreg((3 << 11) | 20) & 0xFu; }
#define XB_SPIN(cond, bar) do { unsigned _sp = 0; while (cond) { __builtin_amdgcn_s_sleep(1); \
    if ((++_sp & 255u) == 0u) { if (xb_ld(&(bar)[XB_TMO])) break; if (_sp > XB_SPIN_CAP) { atomicAdd(&(bar)[XB_TMO], 1u); break; } } } } while (0)
struct XcdBarrier { unsigned* bar; unsigned x; volatile LAS unsigned* st; };
__device__ __forceinline__ XcdBarrier xcd_barrier_post(unsigned* bar, volatile LAS unsigned* st, int tid) {
    XcdBarrier b; b.bar = bar; b.x = xb_xcc_id(); b.st = st;
    if (tid == 0) (void)xb_add(&bar[XB_XCNT(b.x)], 1u);
    return b;
}
__device__ __forceinline__ void xcd_barrier_complete(unsigned* bar, unsigned x, unsigned& nloc, unsigned& nx) {
    const unsigned G = gridDim.x * gridDim.y * gridDim.z;
    unsigned sum, cnt, mine, sp = 0u;
    for (;;) {
        sum = 0u; cnt = 0u; mine = 0u;
#pragma unroll
        for (unsigned j = 0; j < 16; ++j) { const unsigned c = xb_ld(&bar[XB_XCNT(j)]); sum += c; cnt += (c > 0u) ? 1u : 0u; mine = (j == x) ? c : mine; }
        if (sum == G) break;
        __builtin_amdgcn_s_sleep(1);
        if ((++sp & 255u) == 0u) { if (xb_ld(&bar[XB_TMO])) break; if (sp > XB_SPIN_CAP) { atomicAdd(&bar[XB_TMO], 1u); break; } }
    }
    nloc = mine > 0u ? mine : 1u; nx = cnt > 0u ? cnt : 1u;
}
__device__ __forceinline__ void xcd_barrier(const XcdBarrier& b, int tid) {
    asm volatile("s_waitcnt vmcnt(0)" ::: "memory");
    __syncthreads();
    if (tid == 0) {
        unsigned* bar = b.bar;
        __builtin_amdgcn_s_waitcnt(0);
        unsigned nloc = b.st[0], nx = b.st[1];
        if (nloc == 0u) { xcd_barrier_complete(bar, b.x, nloc, nx); b.st[0] = nloc; b.st[1] = nx; }
        const unsigned old = xb_add(&bar[XB_XSUB(b.x)], 1u);
        const unsigned gen = old / nloc;
        if (old + 1u == (gen + 1u) * nloc) {
            __builtin_amdgcn_fence(__ATOMIC_RELEASE, "agent");
            asm volatile("s_waitcnt vmcnt(0)" ::: "memory");
            const unsigned og = xb_add(&bar[XB_TOP], 1u);
            const unsigned tg = og / nx;
            if (og + 1u == (tg + 1u) * nx) xb_add(&bar[XB_TOPGEN], 1u);
            else XB_SPIN(xb_ld(&bar[XB_TOPGEN]) == tg, bar);
            __builtin_amdgcn_fence(__ATOMIC_ACQUIRE, "agent");
            xb_add(&bar[XB_XGEN(b.x)], 1u);
            asm volatile("s_waitcnt vmcnt(0)" ::: "memory");
        } else {
            XB_SPIN(xb_ld(&bar[XB_XGEN(b.x)]) == gen, bar);
            __builtin_amdgcn_fence(__ATOMIC_ACQUIRE, "agent");
            asm volatile("s_waitcnt vmcnt(0)" ::: "memory");
        }
    }
    __syncthreads();
}

constexpr int NPH = 19;
template <int P> __device__ __forceinline__ void run_phase(const Ctx& c) {
    const Args& args = *c.a;
    if constexpr (P == 0) phase_prep(c);
    if constexpr (P == 1) phase_mod0_filt(c);
    if constexpr (P == 2) {
        { pg8::Gemm g{c.ws<bf16_t>(WS_HB), c.ws<bf16_t>(WS_WIN_T), NTOK, ABIN, D}; pg8::StaticOrder S; S.init(NTOK, ABIN, c.G, c.bid);
          pg8::EpiBf16 E{c.ws<bf16_t>(WS_BIG), ABIN, 6, nullptr}; pg8::gemm_phase<decltype(E), pg8::StaticOrder, true, true>(c.lds, g, S, E, c.tid); }
        { pg8::Gemm g{c.ws<bf16_t>(WS_HCTX), c.ws<bf16_t>(WS_WIN_T) + (size_t)512 * D, NCTX, 1024, D}; pg8::StaticOrder S; S.init(NCTX, 1024, c.G, c.bid);
          pg8::EpiBf16 E{c.ws<bf16_t>(WS_KVC), 1024, 1 << 30, nullptr}; pg8::gemm_phase<decltype(E), pg8::StaticOrder, true, true>(c.lds, g, S, E, c.tid); }
    }
    if constexpr (P == 3) { phase_attn(c); phase_gating(c); }
    if constexpr (P == 4) { pg8::Gemm g{c.ws<bf16_t>(WS_MIX), c.ws<bf16_t>(WS_WOUT_T), NTOK, D, D}; pg8::StaticOrder S; S.init(NTOK, D, c.G, c.bid);
        pg8::EpiBf16 E{c.ws<bf16_t>(WS_BIG), D, 1 << 30, nullptr}; pg8::gemm_phase<decltype(E), pg8::StaticOrder, true, true>(c.lds, g, S, E, c.tid); }
    if constexpr (P == 5) phase_ln1(c, 0);
    if constexpr (P == 6) { pg8::Gemm g{c.ws<bf16_t>(WS_HB), c.ws<bf16_t>(WS_WK_T), NTOK, PQN, D}; pg8::StaticOrder S; S.init(NTOK, PQN, c.G, c.bid);
        pg8::EpiF16 E{c.ws<_Float16>(WS_BIG), PQN}; pg8::gemm_phase<decltype(E), pg8::StaticOrder, true, true>(c.lds, g, S, E, c.tid); }
    if constexpr (P == 7) phase_topk(c);
    if constexpr (P == 8) phase_gather_u(c, 0);
    if constexpr (P == 9) phase_gather_v(c, 0);
    if constexpr (P == 10) {
        pg8::Gemm g{c.ws<bf16_t>(WS_HYIN_T), c.ws<bf16_t>(WS_MIX), HY3, NTOK, D}; pg8::StaticOrder S; S.init(HY3, NTOK, c.G, c.bid);
        pg8::EpiBf16 E{c.ws<bf16_t>(WS_BIG), NTOK, 1 << 30, c.in(I_HYBIN)}; pg8::gemm_phase<decltype(E), pg8::StaticOrder, true, true>(c.lds, g, S, E, c.tid); }
    if constexpr (P == 11) phase_hyena_conv(c);
    if constexpr (P == 12) phase_transpose_y(c);
    if constexpr (P == 13) { pg8::Gemm g{c.ws<bf16_t>(WS_HB), c.ws<bf16_t>(WS_HYOUT_T), NTOK, D, D}; pg8::StaticOrder S; S.init(NTOK, D, c.G, c.bid);
        pg8::EpiBf16 E{c.ws<bf16_t>(WS_BIG), D, 1 << 30, nullptr}; pg8::gemm_phase<decltype(E), pg8::StaticOrder, true, true>(c.lds, g, S, E, c.tid); }
    if constexpr (P == 14) phase_ln1(c, 1);
    if constexpr (P == 15) { pg8::Gemm g{c.ws<bf16_t>(WS_HB), c.ws<bf16_t>(WS_WK_T) + (size_t)PQN * D, NTOK, PQN, D}; pg8::StaticOrder S; S.init(NTOK, PQN, c.G, c.bid);
        pg8::EpiF16 E{c.ws<_Float16>(WS_BIG), PQN}; pg8::gemm_phase<decltype(E), pg8::StaticOrder, true, true>(c.lds, g, S, E, c.tid); }
    if constexpr (P == 16) phase_topk(c);
    if constexpr (P == 17) phase_gather_u(c, 1);
    if constexpr (P == 18) phase_gather_v(c, 1);
}
__device__ __forceinline__ int phase_tid(int wave0) {
    int t = wave0 * 64 + (int)__builtin_amdgcn_mbcnt_hi(~0u, __builtin_amdgcn_mbcnt_lo(~0u, 0u)); asm volatile("" : "+v"(t)); return t;
}
__device__ __forceinline__ Ctx make_ctx(const Args* a, unsigned char* lds_raw, int wave0) {
    int t = phase_tid(wave0);
    Ctx c; c.a = a; c.lds = (LAS unsigned char*)lds_raw; c.tid = t; c.lane = c.tid & 63; c.wave = __builtin_amdgcn_readfirstlane(c.tid >> 6); c.G = gridDim.x; c.bid = blockIdx.x; return c;
}
template <int P>
__global__ void __launch_bounds__(NT) phase_kernel(Args args) {
    __shared__ __attribute__((aligned(16))) unsigned char lds_raw[LDS_BYTES];
    const Ctx c = make_ctx(&args, lds_raw, __builtin_amdgcn_readfirstlane((int)threadIdx.x >> 6));
    run_phase<P>(c);
}
#if ONE_LAUNCH
__device__ __forceinline__ XcdBarrier make_xb(const Args* a, unsigned char* lds_raw) { XcdBarrier b; b.bar = (unsigned*)(a->ws + WS_BAR); b.x = xb_xcc_id(); b.st = (volatile LAS unsigned*)((LAS unsigned char*)lds_raw + LDS_BYTES - 16); return b; }
template <int P> __device__ __forceinline__ void run_all(const Args* a, unsigned char* lds_raw, int wave0) {
#ifndef DBG_LO
#define DBG_LO 0
#define DBG_HI NPH
#endif
    if constexpr (P < NPH) {
        if constexpr (P >= DBG_LO && P < DBG_HI) { const Ctx c = make_ctx(a, lds_raw, wave0); run_phase<P>(c); }
        if constexpr (((DUP_MASK >> P) & 1) != 0) { xcd_barrier(make_xb(a, lds_raw), phase_tid(wave0)); const Ctx c2 = make_ctx(a, lds_raw, wave0); run_phase<P>(c2); }
        if constexpr (P + 1 < NPH) { if constexpr (P == 0) cg::this_grid().sync(); else xcd_barrier(make_xb(a, lds_raw), phase_tid(wave0)); run_all<P + 1>(a, lds_raw, wave0); }
    }
}
__global__ void __launch_bounds__(NT) mega(Args args) {
    __shared__ __attribute__((aligned(16))) unsigned char lds_raw[LDS_BYTES];
    volatile LAS unsigned* st = (volatile LAS unsigned*)((LAS unsigned char*)lds_raw + LDS_BYTES - 16);
    const int wave0 = __builtin_amdgcn_readfirstlane((int)threadIdx.x >> 6);
    const int tid0 = phase_tid(wave0);
    if (tid0 == 0) { st[0] = 0u; st[1] = 0u; }
    __syncthreads();
    (void)xcd_barrier_post((unsigned*)(args.ws + WS_BAR), st, tid0);
    run_all<0>(&args, lds_raw, wave0);
}
#endif
template <int P> static void launch_phases(const Args& a, int grid, hipStream_t stream) {
    if constexpr (P < NPH) { hipLaunchKernelGGL(phase_kernel<P>, dim3(grid), dim3(NT), 0, stream, a); launch_phases<P + 1>(a, grid, stream); }
}

extern "C" void kernel_launch(void* const* d_in, const int* in_sizes, int n_in, void* d_out, int out_size, void* d_ws, size_t ws_size, hipStream_t stream) {
    static int grid = 0;
    if (grid == 0) {
        if (n_in != 30 || out_size != NTOK * D || ws_size < WS_END) { fprintf(stderr, "kernel_launch: unexpected shapes (n_in %d out %d ws %zu)\n", n_in, out_size, ws_size); grid = -1; return; }
        int dev = 0, cus = 0, per_cu = 0;
        (void)hipGetDevice(&dev); (void)hipDeviceGetAttribute(&cus, hipDeviceAttributeMultiprocessorCount, dev);
#if ONE_LAUNCH
        (void)hipOccupancyMaxActiveBlocksPerMultiprocessor(&per_cu, (const void*)mega, NT, 0);
#else
        (void)hipOccupancyMaxActiveBlocksPerMultiprocessor(&per_cu, (const void*)phase_kernel<2>, NT, 0);
#endif
        if (per_cu < 1) { fprintf(stderr, "kernel_launch: occupancy query says %d blocks per CU\n", per_cu); grid = -1; return; }
        grid = cus < 256 ? cus : 256;
        grid &= ~7;
    }
    if (grid < 0) return;
    Args a{};
    for (int i = 0; i < 30; ++i) a.in[i] = (const float*)d_in[i];
    a.out = (float*)d_out; a.ws = (unsigned char*)d_ws;
#if ONE_LAUNCH
    {
        a.ph_lo = 0; a.ph_hi = NPH;
        (void)hipMemsetAsync((char*)d_ws + WS_BAR, 0, XCD_BAR_WORDS * sizeof(unsigned), stream);
        void* kargs[] = {&a};
        hipError_t e = hipLaunchCooperativeKernel((const void*)mega, dim3(grid), dim3(NT), kargs, 0, stream);
        if (e != hipSuccess) fprintf(stderr, "cooperative launch failed: %s (grid %d)\n", hipGetErrorString(e), grid);
    }
#else
    a.ph_lo = 0; a.ph_hi = NPH; launch_phases<0>(a, grid, stream);
#endif
}
```

```cpp
#include <hip/hip_runtime.h>
#include <hip/hip_cooperative_groups.h>
#include <cstdio>
#include <cstdint>
namespace cg = cooperative_groups;

#ifndef FFT_PROBE
#define FFT_PROBE 0
#endif
#ifndef DRY_GATHER
#define DRY_GATHER 0
#endif
#ifndef DUP_MASK
#define DUP_MASK 0
#endif
#ifndef ONE_LAUNCH
#define ONE_LAUNCH 1
#endif

#define LAS __attribute__((address_space(3)))
typedef unsigned short bf16_t;
typedef short bf16x8 __attribute__((ext_vector_type(8)));
typedef short s16x4 __attribute__((ext_vector_type(4)));
typedef float f32x4 __attribute__((ext_vector_type(4)));
typedef float f32x16 __attribute__((ext_vector_type(16)));
typedef float f32x2 __attribute__((ext_vector_type(2)));
typedef unsigned u32x4 __attribute__((ext_vector_type(4)));
typedef unsigned u32x2 __attribute__((ext_vector_type(2)));
typedef short v4i16_t __attribute__((ext_vector_type(4)));

constexpr int D = 1024, NBATCH = 2, SEQ = 16384, NTOK = NBATCH * SEQ;
constexpr int CTXL = 256, NCTX = NBATCH * CTXL;
constexpr int ABIN = 2560, HY3 = 3072, PQN = 2048;
constexpr int NT = 512;
constexpr int LDS_BYTES = 160 * 1024;
constexpr float DN_ALPHA = 1.41421356237309515f;
constexpr float LN_EPS = 1e-5f;

constexpr size_t MiB = 1024 * 1024;
constexpr size_t WS_WIN_T   = 0;
constexpr size_t WS_WOUT_T  = 5 * MiB;
constexpr size_t WS_HYIN_T  = 7 * MiB;
constexpr size_t WS_HYOUT_T = 13 * MiB;
constexpr size_t WS_WK_T    = 15 * MiB;
constexpr size_t WS_WS_BF   = 23 * MiB;
constexpr size_t WS_MOD     = 23 * MiB + 256 * 1024;
constexpr size_t WS_MODC    = WS_MOD + 128 * 1024;
constexpr size_t WS_TWODD   = WS_MODC + 32 * 1024;
constexpr size_t WS_TWS     = WS_TWODD + 128 * 1024;
constexpr size_t WS_BAR     = 23 * MiB + 832 * 1024;
constexpr size_t WS_HID2    = 24 * MiB;
constexpr size_t WS_W3T     = 26 * MiB;
constexpr size_t WS_KVC     = 28 * MiB;
constexpr size_t WS_HCTX    = 29 * MiB;
constexpr size_t WS_HB      = 32 * MiB;
constexpr size_t WS_MIX     = 96 * MiB;
constexpr size_t WS_BIG     = 160 * MiB;
constexpr size_t WS_DQ      = 23 * MiB + 576 * 1024;
constexpr size_t WS_FILT    = 352 * MiB;
constexpr size_t WS_TAB8    = 416 * MiB;
constexpr size_t WS_IDX     = 480 * MiB;
constexpr size_t WS_GATE    = 488 * MiB;
constexpr size_t WS_END     = 512 * MiB;

struct Args {
    const float* in[30];
    float* out;
    unsigned char* ws;
    int ph_lo, ph_hi;
};
enum { I_X = 0, I_C, I_CTX, I_CCTX, I_MODW, I_MODB, I_LNG, I_LNB, I_ABWIN, I_ABWOUT, I_RPB, I_GMWS, I_GMBS, I_HYWIN, I_HYBIN, I_HYCW, I_HYCB,
       I_W1, I_B1, I_F1, I_W2, I_B2, I_F2, I_W3, I_HYD, I_HYWOUT, I_PWQ, I_PKEYS, I_PU, I_PV };

__device__ __forceinline__ unsigned f2bf(float f) { unsigned u = __builtin_bit_cast(unsigned, f); return (u + 0x7fffu + ((u >> 16) & 1u)) >> 16; }
__device__ __forceinline__ float bf2f(unsigned b) { return __builtin_bit_cast(float, (b & 0xffffu) << 16); }
__device__ __forceinline__ unsigned pk2(float lo, float hi) { return f2bf(lo) | (f2bf(hi) << 16); }
__device__ __forceinline__ unsigned cvt_pk_bf16(float lo, float hi) { unsigned r; asm volatile("v_cvt_pk_bf16_f32 %0, %1, %2" : "=v"(r) : "v"(lo), "v"(hi)); return r; }
template <int M> __device__ __forceinline__ float sx(float v) {
    return __builtin_bit_cast(float, __builtin_amdgcn_ds_swizzle(__builtin_bit_cast(int, v), (M << 10) | 0x1f));
}
template <int CTRL> __device__ __forceinline__ float dppx(float v) {
    return __builtin_bit_cast(float, __builtin_amdgcn_update_dpp(0, __builtin_bit_cast(int, v), CTRL, 0xf, 0xf, false));
}
__device__ __forceinline__ float lane_get(float v, int srclane) { return __builtin_bit_cast(float, __builtin_amdgcn_ds_bpermute(srclane << 2, __builtin_bit_cast(int, v))); }
__device__ __forceinline__ int lane_geti(int v, int srclane) { return __builtin_amdgcn_ds_bpermute(srclane << 2, v); }
__device__ __forceinline__ float sx32(float v, int lane) { return lane_get(v, lane ^ 32); }
__device__ __forceinline__ float wave_sum(float v, int lane) { v += sx<1>(v); v += sx<2>(v); v += sx<4>(v); v += sx<8>(v); v += sx<16>(v); v += sx32(v, lane); return v; }
__device__ __forceinline__ float wave_max(float v, int lane) { v = fmaxf(v, sx<1>(v)); v = fmaxf(v, sx<2>(v)); v = fmaxf(v, sx<4>(v)); v = fmaxf(v, sx<8>(v)); v = fmaxf(v, sx<16>(v)); v = fmaxf(v, sx32(v, lane)); return v; }
__device__ __forceinline__ float gelu_erf(float v) { return 0.5f * v * (1.0f + erff(v * 0.70710678118654752f)); }

namespace pg8 {
constexpr int BM = 256, BK = 64, HALF = 128, HTB = HALF * BK * 2, STAGE_BYTES = 8 * HTB, NXCD = 8, WGM = 8;
__host__ __device__ __forceinline__ int lds_byte(int r, int c) { const int st = (r >> 4) * 2 + (c >> 5), rr = r & 15, cc = c & 31, ob = rr * 64 + cc * 2; return st * 1024 + (ob ^ (((ob >> 9) & 1) << 5)); }
__host__ __device__ __forceinline__ void stage_rc(int b, int& R, int& C) { const int st = b / 1024, sb = b % 1024, swz = sb ^ (((sb >> 9) & 1) << 5); R = (st >> 1) * 16 + swz / 64; C = (st & 1) * 32 + (swz % 64) / 2; }
__host__ __device__ __forceinline__ int perm32(int rho) { const int n = rho >> 4, i = rho & 15; return 8 * (i >> 2) + 4 * n + (i & 3); }
struct Unit { int pm, pn; };
struct Gemm { const bf16_t* A; const bf16_t* Bt; int M, N, K; };
struct StaticOrder {
    int nM, nN, nwg, G, c;
    __host__ __device__ void init(int M, int N, int G_, int c_) { nM = M / BM; nN = N / BM; nwg = nM * nN; G = G_; c = c_; }
    __host__ __device__ bool next(int i, Unit& u) const {
        const long L = (long)i * G + c; if (L >= nwg) return false;
        int wgid = (int)L; { const int q = nwg / NXCD, r = nwg % NXCD, xcd = wgid % NXCD, off = wgid / NXCD; wgid = (xcd < r ? xcd * (q + 1) : r * (q + 1) + (xcd - r) * q) + off; }
        const int nig = WGM * nN, gid = wgid / nig, fm = gid * WGM, gsz = (nM - fm) < WGM ? (nM - fm) : WGM;
        u.pm = fm + ((wgid % nig) % gsz); u.pn = (wgid % nig) / gsz; return true;
    }
};

__device__ __forceinline__ f32x2 gelu_pk(f32x2 v) {
    const f32x2 av = __builtin_elementwise_abs(v), d = av * 0.2316418882f + 1.0f;
    f32x2 t; t.x = __builtin_amdgcn_rcpf(d.x); t.y = __builtin_amdgcn_rcpf(d.y);
    f32x2 q = t * 0.5307027145f + (-0.7265760135f); q = q * t + 0.7107068705f; q = q * t + (-0.142248368f); q = q * t + 0.127414796f; q = q * t;
    const f32x2 s = (v * v) * (-0.72134752044f);
    f32x2 e; e.x = __builtin_amdgcn_exp2f(s.x); e.y = __builtin_amdgcn_exp2f(s.y);
    const f32x2 m = v * (q * e), r = v - m;
    f32x2 o; o.x = v.x < 0.f ? m.x : r.x; o.y = v.y < 0.f ? m.y : r.y; return o;
}

struct EpiBf16 {
    static constexpr bool PERM = true;
    bf16_t* O; int ldc; int gelu_from_pn; const float* rowbias;
    __device__ __forceinline__ void operator()(const f32x4 (&acc)[2][2][4][2], const Unit& u, int wr, int wc, int fr, int fq) const {
        const int row0 = u.pm * BM + wr * 64 + fr;
        const int col0 = u.pn * BM + wc * 32 + 8 * fq;
        const bool act = u.pn >= gelu_from_pn;
#pragma unroll
        for (int ai = 0; ai < 2; ++ai)
#pragma unroll
            for (int m = 0; m < 4; ++m) {
                const int row = row0 + ai * HALF + m * 16;
                const float rb = rowbias ? rowbias[row] : 0.f;
                bf16_t* rowp = O + (size_t)row * ldc + col0;
#pragma unroll
                for (int bj = 0; bj < 2; ++bj) {
                    f32x4 v0 = acc[ai][bj][m][0] + rb, v1 = acc[ai][bj][m][1] + rb;
                    if (act) { f32x2 a = gelu_pk((f32x2){v0[0], v0[1]}), b = gelu_pk((f32x2){v0[2], v0[3]}), c = gelu_pk((f32x2){v1[0], v1[1]}), d = gelu_pk((f32x2){v1[2], v1[3]});
                        v0 = (f32x4){a.x, a.y, b.x, b.y}; v1 = (f32x4){c.x, c.y, d.x, d.y}; }
                    u32x4 w; w.x = cvt_pk_bf16(v0[0], v0[1]); w.y = cvt_pk_bf16(v0[2], v0[3]); w.z = cvt_pk_bf16(v1[0], v1[1]); w.w = cvt_pk_bf16(v1[2], v1[3]);
                    *(u32x4*)(rowp + bj * HALF) = w;
                }
            }
    }
};
struct EpiF16 {
    static constexpr bool PERM = true;
    _Float16* O; int ldc;
    __device__ __forceinline__ void operator()(const f32x4 (&acc)[2][2][4][2], const Unit& u, int wr, int wc, int fr, int fq) const {
        typedef _Float16 h8 __attribute__((ext_vector_type(8)));
        const int row0 = u.pm * BM + wr * 64 + fr;
        const int col0 = u.pn * BM + wc * 32 + 8 * fq;
#pragma unroll
        for (int ai = 0; ai < 2; ++ai)
#pragma unroll
            for (int m = 0; m < 4; ++m) {
                _Float16* rowp = O + (size_t)(row0 + ai * HALF + m * 16) * ldc + col0;
#pragma unroll
                for (int bj = 0; bj < 2; ++bj) {
                    const f32x4 v0 = acc[ai][bj][m][0], v1 = acc[ai][bj][m][1];
                    h8 w; w[0] = (_Float16)v0[0]; w[1] = (_Float16)v0[1]; w[2] = (_Float16)v0[2]; w[3] = (_Float16)v0[3];
                    w[4] = (_Float16)v1[0]; w[5] = (_Float16)v1[1]; w[6] = (_Float16)v1[2]; w[7] = (_Float16)v1[3];
                    *(h8*)(rowp + bj * HALF) = w;
                }
            }
    }
};
struct EpiRes {
    static constexpr bool PERM = false;
    const float* res; float* out; const float* gate;
    __device__ __forceinline__ void operator()(const f32x4 (&acc)[2][2][4][2], const Unit& u, int wr, int wc, int fr, int fq) const {
        const int rowt = u.pm * BM;
        const float* g = gate + (size_t)(rowt / SEQ) * 6144;
        const int col0 = u.pn * BM + wc * 32 + 4 * fq;
#pragma unroll
        for (int bj = 0; bj < 2; ++bj)
#pragma unroll
            for (int n = 0; n < 2; ++n) {
                const int col = col0 + bj * HALF + n * 16;
                const f32x4 gv = *(const f32x4*)(g + col);
#pragma unroll
                for (int ai = 0; ai < 2; ++ai)
#pragma unroll
                    for (int m = 0; m < 4; ++m) {
                        const size_t off = (size_t)(rowt + ai * HALF + wr * 64 + m * 16 + fr) * D + col;
                        const f32x4 rv = *(const f32x4*)(res + off);
                        *(f32x4*)(out + off) = rv * DN_ALPHA + gv * acc[ai][bj][m][n];
                    }
            }
    }
};

template <class Epi, class Sched, bool ALIGN_EPI = false, bool SP2 = false>
__device__ __forceinline__ void gemm_phase(LAS unsigned char* lds, const Gemm g, const Sched& S, const Epi& E, const int tid) {
    const int wid = __builtin_amdgcn_readfirstlane(tid >> 6), lane = tid & 63, wr = wid >> 2, wc = wid & 3, fr = lane & 15, fq = lane >> 4;
    const int K = g.K, nt = K / BK;
    unsigned voffA[2], voffB[2];
#pragma unroll
    for (int i = 0; i < 2; ++i) { int R, C; stage_rc(tid * 16 + i * 8192, R, C); const int Rb = Epi::PERM ? ((R & ~31) + perm32(R & 31)) : R;
        voffA[i] = (unsigned)(R * K + C) * 2u; voffB[i] = (unsigned)(Rb * K + C) * 2u; }
    const size_t kstep = (size_t)(BK * 2);
    const size_t hstep = (size_t)HALF * K * 2;
    const size_t tstep = 2 * hstep;
    const unsigned ldsw = (unsigned)wid * 1024u;
    const int aoff = lds_byte(wr * 64 + fr, fq * 8), boff = lds_byte(wc * 32 + fr, fq * 8);
#define PG8_SA(b, h) (((b) * 2 + (h)) * HTB)
#define PG8_SB(b, h) ((4 + (b) * 2 + (h)) * HTB)
#define PG8_STAGE(bufoff, gbase, voff) do { _Pragma("unroll") for (int _i = 0; _i < 2; ++_i) \
        __builtin_amdgcn_global_load_lds((const unsigned*)((const char*)(gbase) + (voff)[_i]), (LAS unsigned*)(lds + (bufoff) + ldsw + _i * 8192), 16, 0, 0); } while (0)
#define PG8_LDA(dst, b, h) do { _Pragma("unroll") for (int m = 0; m < 4; ++m) _Pragma("unroll") for (int k = 0; k < 2; ++k) dst[m][k] = *(const LAS bf16x8*)(lds + PG8_SA(b, h) + aoff + m * 2048 + k * 1024); } while (0)
#define PG8_LDB(dst, b, h) do { _Pragma("unroll") for (int n = 0; n < 2; ++n) _Pragma("unroll") for (int k = 0; k < 2; ++k) dst[n][k] = *(const LAS bf16x8*)(lds + PG8_SB(b, h) + boff + n * 2048 + k * 1024); } while (0)
#define PG8_MMA(ai, bj, At, Bt) do { __builtin_amdgcn_s_setprio(1); _Pragma("unroll") for (int m = 0; m < 4; ++m) _Pragma("unroll") for (int n = 0; n < 2; ++n) _Pragma("unroll") for (int k = 0; k < 2; ++k) \
        acc[ai][bj][m][n] = __builtin_amdgcn_mfma_f32_16x16x32_bf16(Bt[n][k], At[m][k], acc[ai][bj][m][n], 0, 0, 0); __builtin_amdgcn_s_setprio(0); } while (0)
#define PG8_WAIT_V(n) asm volatile("s_waitcnt vmcnt(" #n ")" ::: "memory")
#define PG8_WAIT_L(n) asm volatile("s_waitcnt lgkmcnt(" #n ")" ::: "memory")
#define PG8_BAR __builtin_amdgcn_s_barrier()
#define PG8_SCHED __builtin_amdgcn_sched_barrier(0)
    Unit cur, nxt; int ui = 0;
    if (!S.next(0, cur)) return;
    f32x4 acc[2][2][4][2];
#pragma unroll
    for (int a = 0; a < 2; ++a)
#pragma unroll
        for (int b = 0; b < 2; ++b)
#pragma unroll
            for (int m = 0; m < 4; ++m)
#pragma unroll
                for (int n = 0; n < 2; ++n) acc[a][b][m][n] = (f32x4){0.f, 0.f, 0.f, 0.f};
    bf16x8 At[4][2], B0[2][2], B1[2][2];
    const char* cA = (const char*)g.A + (size_t)cur.pm * tstep; const char* cB = (const char*)g.Bt + (size_t)cur.pn * tstep;
    if constexpr (SP2) {
        PG8_STAGE(PG8_SB(0, 0), cB, voffB); PG8_STAGE(PG8_SB(0, 1), cB + hstep, voffB); PG8_STAGE(PG8_SA(0, 0), cA, voffA); PG8_STAGE(PG8_SA(0, 1), cA + hstep, voffA);
        if (wr == 1) PG8_BAR;
        PG8_WAIT_V(2); PG8_BAR;
        PG8_STAGE(PG8_SB(1, 0), cB + kstep, voffB); PG8_STAGE(PG8_SA(1, 0), cA + kstep, voffA); PG8_STAGE(PG8_SB(1, 1), cB + hstep + kstep, voffB);
        PG8_WAIT_V(6); PG8_BAR;
    } else {
        PG8_STAGE(PG8_SB(0, 0), cB, voffB); PG8_STAGE(PG8_SA(0, 0), cA, voffA); PG8_STAGE(PG8_SB(0, 1), cB + hstep, voffB); PG8_STAGE(PG8_SA(0, 1), cA + hstep, voffA);
        if (wr == 1) PG8_BAR;
        PG8_WAIT_V(4); PG8_BAR;
        PG8_STAGE(PG8_SB(1, 0), cB + kstep, voffB); PG8_STAGE(PG8_SA(1, 0), cA + kstep, voffA); PG8_STAGE(PG8_SB(1, 1), cB + hstep + kstep, voffB);
        PG8_WAIT_V(6); PG8_BAR;
    }
    for (;;) {
        const bool has_next = S.next(ui + 1, nxt);
        const char* nA = has_next ? (const char*)g.A + (size_t)nxt.pm * tstep : cA; const char* nB = has_next ? (const char*)g.Bt + (size_t)nxt.pn * tstep : cB;
        for (int t = 0; t < nt; t += 2) {
            const bool last = (t == nt - 2);
            const char* a1 = cA + (size_t)(t + 1) * kstep;
            const char* a2 = last ? nA : cA + (size_t)(t + 2) * kstep; const char* b2 = last ? nB : cB + (size_t)(t + 2) * kstep;
            const char* a3 = a2 + kstep; const char* b3 = b2 + kstep;
            if constexpr (SP2) {
            PG8_LDB(B0, 0, 0); PG8_LDB(B1, 0, 1); PG8_SCHED; PG8_LDA(At, 0, 0); PG8_STAGE(PG8_SA(1, 1), a1 + hstep, voffA);
            PG8_WAIT_V(8); PG8_WAIT_L(0); PG8_BAR; PG8_MMA(0, 0, At, B0); PG8_MMA(0, 1, At, B1); PG8_BAR; PG8_SCHED;
            PG8_LDA(At, 0, 1); PG8_STAGE(PG8_SB(0, 0), b2, voffB); PG8_STAGE(PG8_SB(0, 1), b2 + hstep, voffB); PG8_STAGE(PG8_SA(0, 0), a2, voffA);
            PG8_WAIT_V(8); PG8_WAIT_L(0); PG8_BAR; PG8_MMA(1, 0, At, B0); PG8_MMA(1, 1, At, B1); PG8_BAR; PG8_SCHED;
            PG8_LDB(B0, 1, 0); PG8_LDB(B1, 1, 1); PG8_SCHED; PG8_LDA(At, 1, 0); PG8_STAGE(PG8_SA(0, 1), a2 + hstep, voffA);
            PG8_WAIT_V(8); PG8_WAIT_L(0); PG8_BAR; PG8_MMA(0, 0, At, B0); PG8_MMA(0, 1, At, B1); PG8_BAR; PG8_SCHED;
            PG8_LDA(At, 1, 1); PG8_STAGE(PG8_SB(1, 0), b3, voffB); PG8_STAGE(PG8_SB(1, 1), b3 + hstep, voffB); PG8_STAGE(PG8_SA(1, 0), a3, voffA);
            PG8_WAIT_V(8); PG8_WAIT_L(0); PG8_BAR; PG8_MMA(1, 0, At, B0); PG8_MMA(1, 1, At, B1); PG8_BAR; PG8_SCHED;
            } else {
            PG8_LDB(B0, 0, 0); PG8_SCHED; PG8_LDA(At, 0, 0); PG8_STAGE(PG8_SA(1, 1), a1 + hstep, voffA);
            PG8_WAIT_L(8); PG8_BAR; PG8_WAIT_L(0); PG8_MMA(0, 0, At, B0); PG8_BAR; PG8_SCHED;
            PG8_LDB(B1, 0, 1); PG8_STAGE(PG8_SB(0, 0), b2, voffB);
            PG8_BAR; PG8_WAIT_L(0); PG8_MMA(0, 1, At, B1); PG8_BAR;
            PG8_LDA(At, 0, 1); PG8_STAGE(PG8_SA(0, 0), a2, voffA);
            PG8_BAR; PG8_WAIT_L(0); PG8_MMA(1, 0, At, B0); PG8_BAR; PG8_SCHED;
            PG8_STAGE(PG8_SB(0, 1), b2 + hstep, voffB);
            PG8_WAIT_V(6); PG8_BAR; PG8_MMA(1, 1, At, B1); PG8_BAR;
            PG8_LDB(B0, 1, 0); PG8_SCHED; PG8_LDA(At, 1, 0); PG8_STAGE(PG8_SA(0, 1), a2 + hstep, voffA);
            PG8_WAIT_L(8); PG8_BAR; PG8_WAIT_L(0); PG8_MMA(0, 0, At, B0); PG8_BAR; PG8_SCHED;
            PG8_LDB(B1, 1, 1); PG8_STAGE(PG8_SB(1, 0), b3, voffB);
            PG8_BAR; PG8_WAIT_L(0); PG8_MMA(0, 1, At, B1); PG8_BAR;
            PG8_LDA(At, 1, 1); PG8_STAGE(PG8_SA(1, 0), a3, voffA);
            PG8_BAR; PG8_WAIT_L(0); PG8_MMA(1, 0, At, B0); PG8_BAR; PG8_SCHED;
            PG8_STAGE(PG8_SB(1, 1), b3 + hstep, voffB);
            PG8_WAIT_V(6); PG8_BAR; PG8_MMA(1, 1, At, B1); PG8_BAR;
            }
        }
        if constexpr (ALIGN_EPI) { if (wr == 0) PG8_BAR; }
        E(acc, cur, wr, wc, fr, fq);
        if (!has_next) break;
#pragma unroll
        for (int a = 0; a < 2; ++a)
#pragma unroll
            for (int b = 0; b < 2; ++b)
#pragma unroll
                for (int m = 0; m < 4; ++m)
#pragma unroll
                    for (int n = 0; n < 2; ++n) acc[a][b][m][n] = (f32x4){0.f, 0.f, 0.f, 0.f};
        cur = nxt; cA = nA; cB = nB; ++ui;
        if constexpr (ALIGN_EPI) { if (wr == 1) PG8_BAR; }
    }
    PG8_WAIT_V(0);
    if constexpr (!ALIGN_EPI) { if (wr == 0) PG8_BAR; }
    PG8_BAR;
#undef PG8_SA
#undef PG8_SB
#undef PG8_STAGE
#undef PG8_LDA
#undef PG8_LDB
#undef PG8_MMA
#undef PG8_WAIT_V
#undef PG8_WAIT_L
#undef PG8_BAR
#undef PG8_SCHED
}
}

struct Ctx {
    const Args* a; LAS unsigned char* lds; int tid, lane, wave, G, bid;
    template <class T> __device__ __forceinline__ T* ws(size_t off) const { return (T*)(a->ws + off); }
    __device__ __forceinline__ const float* in(int i) const { return a->in[i]; }
};

__device__ void transpose_cvt(const Ctx& c, const float* in, bf16_t* out, int K, int N) {
    LAS float* t = (LAS float*)c.lds;
    const int tk = K / 64, tn = N / 64;
    for (int tile = c.bid; tile < tk * tn; tile += c.G) {
        const int k0 = (tile / tn) * 64, n0 = (tile % tn) * 64;
        __syncthreads();
#pragma unroll
        for (int i = 0; i < 8; ++i) { const int e = c.tid + i * NT, r = e >> 6, cc = e & 63; t[r * 65 + cc] = in[(size_t)(k0 + r) * N + n0 + cc]; }
        __syncthreads();
#pragma unroll
        for (int i = 0; i < 8; ++i) { const int e = c.tid + i * NT, r = e >> 6, cc = e & 63; out[(size_t)(n0 + r) * K + k0 + cc] = (bf16_t)f2bf(t[cc * 65 + r]); }
    }
    __syncthreads();
}

__device__ void phase_prep(const Ctx& c) {
    transpose_cvt(c, c.in(I_ABWIN), c.ws<bf16_t>(WS_WIN_T), D, ABIN);
    transpose_cvt(c, c.in(I_ABWOUT), c.ws<bf16_t>(WS_WOUT_T), D, D);
    transpose_cvt(c, c.in(I_HYWIN), c.ws<bf16_t>(WS_HYIN_T), D, HY3);
    transpose_cvt(c, c.in(I_HYWOUT), c.ws<bf16_t>(WS_HYOUT_T), D, D);
    {
        LAS float* sv = (LAS float*)c.lds;
        LAS float* red = sv + 3 * 1024;
        __syncthreads();
        for (int e = c.tid; e < 3 * 1024; e += NT) { const int w = e >> 10, k = e & 1023; const float v = w < 2 ? c.in(I_C)[w * D + k] : c.in(I_CCTX)[k]; sv[e] = v / (1.0f + __expf(-v)); }
        __syncthreads();
        const int jj = c.tid & 63, kg = c.tid >> 6;
        for (int item = c.bid; item < 2 * 96; item += c.G) {
            const int layer = item / 96, j = (item % 96) * 64 + jj;
            const float* w = c.in(I_MODW) + (size_t)layer * D * 6144 + j;
            float a0 = 0.f, a1 = 0.f, a2 = 0.f;
#pragma unroll 8
            for (int kk = 0; kk < 128; ++kk) { const int k = kg * 128 + kk; const float wv = w[(size_t)k * 6144]; a0 += sv[k] * wv; a1 += sv[1024 + k] * wv; a2 += sv[2048 + k] * wv; }
            red[(0 * 8 + kg) * 64 + jj] = a0; red[(1 * 8 + kg) * 64 + jj] = a1; red[(2 * 8 + kg) * 64 + jj] = a2;
            __syncthreads();
            if (c.tid < 192) { const int w3 = c.tid >> 6; float s = 0.f;
#pragma unroll
                for (int q = 0; q < 8; ++q) s += red[(w3 * 8 + q) * 64 + jj];
                s += c.in(I_MODB)[layer * 6144 + j];
                if (w3 < 2) c.ws<float>(WS_MOD)[(layer * 2 + w3) * 6144 + j] = s; else if (layer == 0) c.ws<float>(WS_MODC)[j] = s; }
            __syncthreads();
        }
    }
    {
        LAS float* z = (LAS float*)c.lds;
        LAS float* h1 = z + 8 * 40;
        const int tt = c.tid >> 6, j = c.tid & 63;
        for (int item = c.bid; item < SEQ / 8; item += c.G) {
            __syncthreads();
            if (c.tid < 8 * 33) { const int t8 = c.tid / 33, e = c.tid % 33, t = item * 8 + t8; float v;
                if (e == 0) v = (float)((double)t / (double)(SEQ - 1));
                else { const int k = (e - 1) & 15; const double band = 1e-4 + (double)k * ((15.0 - 1e-4) / 15.0); const double rev = 2.0 * band * (double)t / (double)SEQ;
                    v = (e <= 16) ? (float)cospi(rev) : (float)(-sinpi(rev)); }
                z[t8 * 40 + e] = v; }
            __syncthreads();
            { float s = c.in(I_B1)[j];
#pragma unroll
              for (int e = 0; e < 33; ++e) s += z[tt * 40 + e] * c.in(I_W1)[e * 64 + j];
              h1[tt * 64 + j] = sinf(c.in(I_F1)[j] * s); }
            __syncthreads();
            { float s = c.in(I_B2)[j];
#pragma unroll 8
              for (int m = 0; m < 64; ++m) s += h1[tt * 64 + m] * c.in(I_W2)[m * 64 + j];
              c.ws<bf16_t>(WS_HID2)[(size_t)(item * 8 + tt) * 64 + j] = (bf16_t)f2bf(sinf(c.in(I_F2)[j] * s)); }
        }
        __syncthreads();
    }
    {
        LAS bf16_t* kyb = (LAS bf16_t*)c.lds;
        LAS bf16_t* wqb = kyb + 128 * 136;
        const int l31 = c.lane & 31, hh = c.lane >> 5;
        for (int item = c.bid; item < 2 * 16 * 8; item += c.G) {
            const int layer = item / 128, hp = (item / 8) % 16, kt = item % 8;
            __syncthreads();
#pragma unroll
            for (int i = 0; i < 8; ++i) { const int idx = c.tid + i * NT, r = idx >> 5, q4 = (idx & 31) * 4;
                const f32x4 kv = *(const f32x4*)(c.in(I_PKEYS) + (((size_t)layer * 16 + hp) * 128 + r) * 128 + q4);
                const f32x4 wv = *(const f32x4*)(c.in(I_PWQ) + ((size_t)layer * D + kt * 128 + r) * PQN + hp * 128 + q4);
                *(LAS u32x2*)(kyb + r * 136 + q4) = (u32x2){pk2(kv[0], kv[1]), pk2(kv[2], kv[3])};
                *(LAS u32x2*)(wqb + r * 136 + q4) = (u32x2){pk2(wv[0], wv[1]), pk2(wv[2], wv[3])}; }
            __syncthreads();
            const int mt = c.wave & 3, ntb = (c.wave >> 2) * 2;
            f32x16 acc[2];
#pragma unroll
            for (int j = 0; j < 2; ++j)
#pragma unroll
                for (int i = 0; i < 16; ++i) acc[j][i] = 0.f;
#pragma unroll
            for (int ks = 0; ks < 8; ++ks) {
                const bf16x8 af = *(const LAS bf16x8*)(kyb + (mt * 32 + l31) * 136 + ks * 16 + hh * 8);
#pragma unroll
                for (int j = 0; j < 2; ++j) { const bf16x8 bfr = *(const LAS bf16x8*)(wqb + ((ntb + j) * 32 + l31) * 136 + ks * 16 + hh * 8);
                    acc[j] = __builtin_amdgcn_mfma_f32_32x32x16_bf16(af, bfr, acc[j], 0, 0, 0); }
            }
            bf16_t* o = c.ws<bf16_t>(WS_WK_T) + ((size_t)layer * PQN + hp * 128) * D + kt * 128;
#pragma unroll
            for (int j = 0; j < 2; ++j)
#pragma unroll
                for (int i = 0; i < 16; ++i) { const int key = mt * 32 + (i & 3) + 8 * (i >> 2) + 4 * hh;
                    o[(size_t)key * D + (ntb + j) * 32 + l31] = (bf16_t)f2bf(acc[j][i]); }
        }
        __syncthreads();
    }
    for (int e = c.bid * NT + c.tid; e < 4 * 128 * 128; e += c.G * NT) c.ws<bf16_t>(WS_WS_BF)[e] = (bf16_t)f2bf(c.in(I_GMWS)[e]);
    for (int e = c.bid * NT + c.tid; e < 64 * 2048; e += c.G * NT) { const int j = e >> 11, col = e & 2047; c.ws<bf16_t>(WS_W3T)[col * 64 + j] = (bf16_t)f2bf(c.in(I_W3)[e]); }
    for (int e = c.bid * NT + c.tid; e < 16384 + 1024 + 64 + 4; e += c.G * NT) {
        double rev; f32x2* dst;
        if (e < 16384) { rev = (double)e / 32768.0; dst = c.ws<f32x2>(WS_TWODD) + e; }
        else if (e < 16384 + 1024) { rev = (double)(e - 16384) / 16384.0; dst = c.ws<f32x2>(WS_TWS) + (e - 16384); }
        else if (e < 16384 + 1024 + 64) { rev = (double)(e - 17408) / 1024.0; dst = c.ws<f32x2>(WS_TWS) + (e - 16384); }
        else { rev = (double)(e - 17472) / 64.0; dst = c.ws<f32x2>(WS_TWS) + (e - 16384); }
        double sn, cs; sincospi(-2.0 * rev, &sn, &cs);
        *dst = (f32x2){(float)cs, (float)sn};
    }
    {
        typedef float v16f __attribute__((ext_vector_type(16)));
        typedef unsigned v6u __attribute__((ext_vector_type(6)));
        const int hh = c.lane >> 5, r = c.lane & 31;
        for (int row0 = (c.bid * 8 + c.wave) * 4; row0 < 4 * 16384; row0 += c.G * 8 * 4) {
            f32x4 v[2][8]; float mx[2];
#pragma unroll
            for (int q = 0; q < 2; ++q) { const int row = row0 + 2 * q + hh, which = row >> 14, rr = row & 16383, layer = which >> 1;
                const float* src = ((which & 1) ? c.in(I_PV) : c.in(I_PU)) + ((size_t)layer * 16384 + rr) * D + 4 * r;
#pragma unroll
                for (int m = 0; m < 8; ++m) v[q][m] = __builtin_nontemporal_load((const f32x4*)(src + 128 * m)); }
#pragma unroll
            for (int q = 0; q < 2; ++q) { float x = 0.f;
#pragma unroll
                for (int m = 0; m < 8; ++m) x = fmaxf(x, fmaxf(fmaxf(fabsf(v[q][m][0]), fabsf(v[q][m][1])), fmaxf(fabsf(v[q][m][2]), fabsf(v[q][m][3]))));
                mx[q] = x; }
#pragma unroll
            for (int q = 0; q < 2; ++q) { float x = mx[q]; x = fmaxf(x, sx<16>(x)); x = fmaxf(x, sx<8>(x)); x = fmaxf(x, sx<4>(x)); x = fmaxf(x, sx<2>(x)); x = fmaxf(x, sx<1>(x)); mx[q] = x; }
#pragma unroll
            for (int q = 0; q < 2; ++q) { const int row = row0 + 2 * q + hh; const float m1 = fmaxf(mx[q], 1e-30f), sc = 7.0f / m1;
                v16f a, bb;
#pragma unroll
                for (int i = 0; i < 16; ++i) { a[i] = v[q][i >> 1][2 * (i & 1)] * sc; bb[i] = v[q][i >> 1][2 * (i & 1) + 1] * sc; }
                const v6u p = __builtin_amdgcn_cvt_scalef32_2xpk16_fp6_f32(a, bb, 1.0f);
                unsigned char* dst = c.ws<unsigned char>(WS_TAB8) + (size_t)row * 768 + 24 * r;
                *(u32x2*)dst = (u32x2){p[0], p[1]}; *(u32x2*)(dst + 8) = (u32x2){p[2], p[3]}; *(u32x2*)(dst + 16) = (u32x2){p[4], p[5]};
                if (r == 0) c.ws<float>(WS_DQ)[(((row >> 15) * 16384) + (row & 16383)) * 2 + ((row >> 14) & 1)] = m1 * (1.0f / 7.0f); }
        }
    }
}

__device__ void modulate_rows(const Ctx& c, const float* x, bf16_t* out, int rows, int rows_per_batch, const float* sh, const float* sc, int bstride) {
    const int total = rows * (D / 8);
    for (int e = c.bid * NT + c.tid; e < total; e += c.G * NT) {
        const int r = e >> 7, c8 = (e & 127) * 8, b = r / rows_per_batch;
        const f32x4 x0 = *(const f32x4*)(x + (size_t)r * D + c8), x1 = *(const f32x4*)(x + (size_t)r * D + c8 + 4);
        const f32x4 s0 = *(const f32x4*)(sc + b * bstride + c8), s1 = *(const f32x4*)(sc + b * bstride + c8 + 4);
        const f32x4 h0 = *(const f32x4*)(sh + b * bstride + c8), h1 = *(const f32x4*)(sh + b * bstride + c8 + 4);
        const f32x4 y0 = x0 * (s0 + 1.0f) + h0, y1 = x1 * (s1 + 1.0f) + h1;
        u32x4 w; w.x = pk2(y0[0], y0[1]); w.y = pk2(y0[2], y0[3]); w.z = pk2(y1[0], y1[1]); w.w = pk2(y1[2], y1[3]);
        *(u32x4*)(out + (size_t)r * D + c8) = w;
    }
}

__device__ void phase_mod0_filt(const Ctx& c) {
    const float* mod0 = c.ws<float>(WS_MOD);
    modulate_rows(c, c.in(I_X), c.ws<bf16_t>(WS_HB), NTOK, SEQ, mod0, mod0 + 1024, 6144);
    const float* modc = c.ws<float>(WS_MODC);
    modulate_rows(c, c.in(I_CTX), c.ws<bf16_t>(WS_HCTX), NCTX, NCTX, modc, modc + 1024, 0);
    {
        const bf16_t* W3T = c.ws<bf16_t>(WS_W3T); const bf16_t* H2 = c.ws<bf16_t>(WS_HID2); bf16_t* FILT = c.ws<bf16_t>(WS_FILT);
        const int l31 = c.lane & 31, hh = c.lane >> 5;
        const float d0 = 3.0701134573253943f, d1 = 15.350567286626972f;
        for (int item = c.bid * 8 + c.wave; item < 64 * 512; item += c.G * 8) {
            const int col0 = (item >> 9) * 32, t0 = (item & 511) * 32;
            f32x16 acc;
#pragma unroll
            for (int i = 0; i < 16; ++i) acc[i] = 0.f;
#pragma unroll
            for (int ks = 0; ks < 4; ++ks) {
                const bf16x8 af = *(const bf16x8*)(W3T + (size_t)(col0 + l31) * 64 + ks * 16 + hh * 8);
                const bf16x8 bfr = *(const bf16x8*)(H2 + (size_t)(t0 + l31) * 64 + ks * 16 + hh * 8);
                acc = __builtin_amdgcn_mfma_f32_32x32x16_bf16(af, bfr, acc, 0, 0, 0);
            }
            const int t = t0 + l31;
            const float tn = (float)t * (1.0f / (float)(SEQ - 1));
#pragma unroll
            for (int i = 0; i < 16; ++i) { const int col = col0 + (i & 3) + 8 * (i >> 2) + 4 * hh, ch = col & 1023;
                const float delta = d0 + (float)ch * ((d1 - d0) / 1023.0f);
                const float val = acc[i] * __expf(-tn * delta);
                if (col < 1024) FILT[(size_t)ch * SEQ + t] = (bf16_t)f2bf(val);
                else FILT[(size_t)(1024 + ch) * SEQ + ((SEQ - t) & (SEQ - 1))] = (bf16_t)(t ? f2bf(val) : 0u); }
        }
    }
}

__device__ void phase_attn(const Ctx& c) {
    LAS float* rpb = (LAS float*)c.lds + 64;
    LAS unsigned char* vt = c.lds + 16384 + c.wave * 6144;
    __syncthreads();
    for (int e = c.tid; e < 8 * 15 * 31; e += NT) rpb[e] = c.in(I_RPB)[e] * 1.44269504088896341f;
    __syncthreads();
    const bf16_t* P = c.ws<bf16_t>(WS_BIG);
    const bf16_t* KVC = c.ws<bf16_t>(WS_KVC);
    bf16_t* MIXO = c.ws<bf16_t>(WS_MIX);
    const int lane = c.lane, h = c.wave, l31 = lane & 31, hh = lane >> 5;
    const int gg = lane >> 4, li = lane & 15;
    for (int item = c.bid; item < NBATCH * 256; item += c.G) {
        const int b = item >> 8, r = item & 255;
        const int rs = min(max(r - 4, 0), 248);
        const size_t tok0 = (size_t)b * SEQ + (size_t)r * 64;
        bf16x8 qf[2][4];
#pragma unroll
        for (int nt = 0; nt < 2; ++nt)
#pragma unroll
            for (int s = 0; s < 4; ++s) qf[nt][s] = *(const bf16x8*)(P + (tok0 + nt * 32 + l31) * ABIN + h * 64 + s * 16 + hh * 8);
        f32x16 o[2][2];
#pragma unroll
        for (int nt = 0; nt < 2; ++nt)
#pragma unroll
            for (int mt = 0; mt < 2; ++mt)
#pragma unroll
                for (int i = 0; i < 16; ++i) o[nt][mt][i] = 0.f;
        float mrun[2] = {-1e30f, -1e30f}, lrun[2] = {0.f, 0.f};
        for (int kt = 0; kt < 24; ++kt) {
            const bool isctx = kt < 8;
            const bf16_t *kbase, *vbase; size_t kstride; int rr = 0, c0 = 0;
            if (isctx) { const size_t row0 = (size_t)b * CTXL + kt * 32; kbase = KVC + row0 * 1024 + h * 64; vbase = kbase + 512; kstride = 1024; }
            else { const int lt = kt - 8; rr = rs + (lt >> 1); c0 = (lt & 1) * 32; const size_t row0 = (size_t)b * SEQ + (size_t)rr * 64 + c0; kbase = P + row0 * ABIN + 512 + h * 64; vbase = kbase + 512; kstride = ABIN; }
#pragma unroll
            for (int it = 0; it < 4; ++it) { const int key = it * 8 + (lane >> 3), ch = lane & 7;
                const u32x4 v = *(const u32x4*)(vbase + (size_t)key * kstride + ch * 8);
                *(LAS u32x4*)(vt + key * 192 + ch * 16) = v; }
            bf16x8 kf[4];
#pragma unroll
            for (int s = 0; s < 4; ++s) kf[s] = *(const bf16x8*)(kbase + (size_t)l31 * kstride + s * 16 + hh * 8);
            bf16x8 pf[2][2];
#pragma unroll
            for (int nt = 0; nt < 2; ++nt) {
                f32x16 st;
#pragma unroll
                for (int i = 0; i < 16; ++i) st[i] = 0.f;
#pragma unroll
                for (int s = 0; s < 4; ++s) st = __builtin_amdgcn_mfma_f32_32x32x16_bf16(kf[s], qf[nt][s], st, 0, 0, 0);
                float mx = -INFINITY;
                if (isctx) {
#pragma unroll
                    for (int i = 0; i < 16; ++i) { st[i] *= 0.125f * 1.44269504088896341f; mx = fmaxf(mx, st[i]); }
                } else {
                    const int qc = nt * 32 + l31, cs = min(max(qc - 8, 0), 48);
                    const LAS float* rp = rpb + (h * 15 + (rr - r + 7)) * 31 + 15 - qc + c0 + 4 * hh;
                    const unsigned kb = (unsigned)(c0 + 4 * hh - cs);
                    float bias[16];
#pragma unroll
                    for (int i = 0; i < 16; ++i) bias[i] = rp[(i & 3) + 8 * (i >> 2)];
#pragma unroll
                    for (int i = 0; i < 16; ++i) asm volatile("" : "+v"(bias[i]));
#pragma unroll
                    for (int i = 0; i < 16; ++i) { const bool valid = (kb + (unsigned)((i & 3) + 8 * (i >> 2))) < 16u;
                        st[i] = valid ? st[i] * (0.125f * 1.44269504088896341f) + bias[i] : -INFINITY; mx = fmaxf(mx, st[i]); }
                }
                mx = fmaxf(mx, sx32(mx, lane));
                if (__builtin_amdgcn_ballot_w64(mx > mrun[nt] + 8.0f) != 0ull) {
                    const float mnew = fmaxf(mrun[nt], mx), alpha = __builtin_amdgcn_exp2f(mrun[nt] - mnew);
                    lrun[nt] *= alpha; mrun[nt] = mnew;
#pragma unroll
                    for (int mt = 0; mt < 2; ++mt)
#pragma unroll
                        for (int i = 0; i < 16; ++i) o[nt][mt][i] *= alpha;
                }
                float ls = 0.f;
#pragma unroll
                for (int i = 0; i < 16; ++i) { st[i] = __builtin_amdgcn_exp2f(st[i] - mrun[nt]); ls += st[i]; }
                ls += sx32(ls, lane);
                lrun[nt] += ls;
#pragma unroll
                for (int s2 = 0; s2 < 2; ++s2) { u32x4 w; w.x = cvt_pk_bf16(st[8 * s2], st[8 * s2 + 1]); w.y = cvt_pk_bf16(st[8 * s2 + 2], st[8 * s2 + 3]);
                    w.z = cvt_pk_bf16(st[8 * s2 + 4], st[8 * s2 + 5]); w.w = cvt_pk_bf16(st[8 * s2 + 6], st[8 * s2 + 7]); pf[nt][s2] = __builtin_bit_cast(bf16x8, w); }
            }
#pragma unroll
            for (int mt = 0; mt < 2; ++mt)
#pragma unroll
                for (int s2 = 0; s2 < 2; ++s2) {
                    const int key0 = 16 * s2 + 4 * hh + (li >> 2), colb = (mt * 32 + 16 * (gg & 1) + 4 * (li & 3)) * 2;
                    const s16x4 lo = __builtin_bit_cast(s16x4, __builtin_amdgcn_ds_read_tr16_b64_v4i16((LAS v4i16_t*)(vt + key0 * 192 + colb)));
                    const s16x4 hi = __builtin_bit_cast(s16x4, __builtin_amdgcn_ds_read_tr16_b64_v4i16((LAS v4i16_t*)(vt + (key0 + 8) * 192 + colb)));
                    bf16x8 vf; vf[0] = lo[0]; vf[1] = lo[1]; vf[2] = lo[2]; vf[3] = lo[3]; vf[4] = hi[0]; vf[5] = hi[1]; vf[6] = hi[2]; vf[7] = hi[3];
#pragma unroll
                    for (int nt = 0; nt < 2; ++nt) o[nt][mt] = __builtin_amdgcn_mfma_f32_32x32x16_bf16(vf, pf[nt][s2], o[nt][mt], 0, 0, 0);
                }
        }
#pragma unroll
        for (int nt = 0; nt < 2; ++nt) {
            const float inv = 1.0f / lrun[nt];
            bf16_t* op = MIXO + (tok0 + nt * 32 + l31) * D + h * 64;
#pragma unroll
            for (int mt = 0; mt < 2; ++mt)
#pragma unroll
                for (int gi = 0; gi < 4; ++gi) { u32x2 w; w.x = cvt_pk_bf16(o[nt][mt][4 * gi] * inv, o[nt][mt][4 * gi + 1] * inv); w.y = cvt_pk_bf16(o[nt][mt][4 * gi + 2] * inv, o[nt][mt][4 * gi + 3] * inv);
                    *(u32x2*)(op + mt * 32 + 8 * gi + 4 * hh) = w; }
        }
    }
    __syncthreads();
}

__device__ void phase_gating(const Ctx& c) {
    constexpr int RS = 1088;
    const bf16_t* P = c.ws<bf16_t>(WS_BIG);
    bf16_t* MIXO = c.ws<bf16_t>(WS_MIX);
    const bf16_t* WS = c.ws<bf16_t>(WS_WS_BF);
    const float* BS = c.in(I_GMBS);
    const int lane = c.lane, l31 = lane & 31, hh = lane >> 5, gg = lane >> 4, li = lane & 15;
    for (int item = c.bid; item < NTOK / 128; item += c.G) {
        const size_t tok0 = (size_t)item * 128;
        __syncthreads();
        for (int rw = 0; rw < 16; ++rw) {
            const int row = c.wave * 16 + rw;
            const u32x4 raw = *(const u32x4*)(P + (tok0 + row) * ABIN + 2048 + lane * 8);
            float v[8]; v[0] = bf2f(raw.x); v[1] = bf2f(raw.x >> 16); v[2] = bf2f(raw.y); v[3] = bf2f(raw.y >> 16); v[4] = bf2f(raw.z); v[5] = bf2f(raw.z >> 16); v[6] = bf2f(raw.w); v[7] = bf2f(raw.w >> 16);
            float s = 0.f;
#pragma unroll
            for (int i = 0; i < 8; ++i) s += v[i];
            const float mean = wave_sum(s, lane) * (1.0f / 512.0f);
            float q = 0.f;
#pragma unroll
            for (int i = 0; i < 8; ++i) { v[i] -= mean; q += v[i] * v[i]; }
            const float rstd = rsqrtf(wave_sum(q, lane) * (1.0f / 512.0f) + LN_EPS);
            u32x4 w; w.x = pk2(v[0] * rstd, v[1] * rstd); w.y = pk2(v[2] * rstd, v[3] * rstd); w.z = pk2(v[4] * rstd, v[5] * rstd); w.w = pk2(v[6] * rstd, v[7] * rstd);
            *(LAS u32x4*)(c.lds + row * RS + lane * 16) = w;
        }
        __syncthreads();
        const int g = c.wave >> 1, ph = c.wave & 1;
        f32x16 acc[2][4];
#pragma unroll
        for (int mt = 0; mt < 2; ++mt)
#pragma unroll
            for (int ct = 0; ct < 4; ++ct)
#pragma unroll
                for (int i = 0; i < 16; ++i) acc[mt][ct][i] = 0.f;
        for (int ks = 0; ks < 8; ++ks) {
            bf16x8 af[2];
#pragma unroll
            for (int mt = 0; mt < 2; ++mt) af[mt] = *(const bf16x8*)(WS + ((size_t)g * 128 + ph * 64 + mt * 32 + l31) * 128 + ks * 16 + hh * 8);
#pragma unroll
            for (int ct = 0; ct < 4; ++ct) {
                const int q0 = 16 * ks + 8 * hh + (li >> 2), colb = (g * 128 + ct * 32 + 16 * (gg & 1) + 4 * (li & 3)) * 2;
                const s16x4 lo = __builtin_bit_cast(s16x4, __builtin_amdgcn_ds_read_tr16_b64_v4i16((LAS v4i16_t*)(c.lds + q0 * RS + colb)));
                const s16x4 hi = __builtin_bit_cast(s16x4, __builtin_amdgcn_ds_read_tr16_b64_v4i16((LAS v4i16_t*)(c.lds + (q0 + 4) * RS + colb)));
                bf16x8 bfr; bfr[0] = lo[0]; bfr[1] = lo[1]; bfr[2] = lo[2]; bfr[3] = lo[3]; bfr[4] = hi[0]; bfr[5] = hi[1]; bfr[6] = hi[2]; bfr[7] = hi[3];
#pragma unroll
                for (int mt = 0; mt < 2; ++mt) acc[mt][ct] = __builtin_amdgcn_mfma_f32_32x32x16_bf16(bfr, af[mt], acc[mt][ct], 0, 0, 0);
            }
        }
#pragma unroll
        for (int mt = 0; mt < 2; ++mt) {
            const int p = ph * 64 + mt * 32 + l31;
            const float bs = BS[g * 128 + p];
#pragma unroll
            for (int ct = 0; ct < 4; ++ct)
#pragma unroll
                for (int gi = 0; gi < 4; ++gi) {
                    const int col = g * 128 + ct * 32 + 8 * gi + 4 * hh;
                    const u32x2 uu = *(const u32x2*)(P + (tok0 + p) * ABIN + 1536 + col);
                    u32x2 w; w.x = pk2(bf2f(uu.x) * (acc[mt][ct][4 * gi] + bs), bf2f(uu.x >> 16) * (acc[mt][ct][4 * gi + 1] + bs));
                    w.y = pk2(bf2f(uu.y) * (acc[mt][ct][4 * gi + 2] + bs), bf2f(uu.y >> 16) * (acc[mt][ct][4 * gi + 3] + bs));
                    *(u32x2*)(MIXO + (tok0 + p) * D + 512 + col) = w;
                }
        }
    }
    __syncthreads();
}

template <int CM = 0> __device__ __forceinline__ void ln_row(float (&v)[16], const float* g, const float* b, int lane) {
    float s = 0.f;
#pragma unroll
    for (int i = 0; i < 16; ++i) s += v[i];
    const float mean = wave_sum(s, lane) * (1.0f / 1024.0f);
    float q = 0.f;
#pragma unroll
    for (int i = 0; i < 16; ++i) { v[i] -= mean; q += v[i] * v[i]; }
    const float rstd = rsqrtf(wave_sum(q, lane) * (1.0f / 1024.0f) + LN_EPS);
#pragma unroll
    for (int m = 0; m < 4; ++m) { const int col = CM == 3 ? 128 * (4 * (lane >> 5) + m) + 4 * (lane & 31) : (CM == 2 ? 32 * (lane & 31) + 16 * (lane >> 5) + 4 * m : (CM == 1 ? 16 * lane + 4 * m : 256 * m + 4 * lane)); const f32x4 gv = *(const f32x4*)(g + col), bv = *(const f32x4*)(b + col);
#pragma unroll
        for (int e = 0; e < 4; ++e) v[4 * m + e] = v[4 * m + e] * rstd * gv[e] + bv[e]; }
}
template <int CM = 0> __device__ __forceinline__ void store_mod_bf16(const float (&v)[16], bf16_t* dst, const float* sh, const float* sc, int lane) {
#pragma unroll
    for (int m = 0; m < 4; ++m) { const int col = CM == 3 ? 128 * (4 * (lane >> 5) + m) + 4 * (lane & 31) : (CM == 2 ? 32 * (lane & 31) + 16 * (lane >> 5) + 4 * m : (CM == 1 ? 16 * lane + 4 * m : 256 * m + 4 * lane)); const f32x4 s = *(const f32x4*)(sc + col), h = *(const f32x4*)(sh + col);
        u32x2 w; w.x = pk2(v[4 * m] * (1.0f + s[0]) + h[0], v[4 * m + 1] * (1.0f + s[1]) + h[1]); w.y = pk2(v[4 * m + 2] * (1.0f + s[2]) + h[2], v[4 * m + 3] * (1.0f + s[3]) + h[3]);
        *(u32x2*)(dst + col) = w; }
}

__device__ __forceinline__ bf16_t* resid_buf(const Ctx& c, int which) { return which < 2 ? (bf16_t*)c.a->out + (size_t)which * NTOK * D : c.ws<bf16_t>(WS_MIX); }
__device__ void phase_ln1(const Ctx& c, int layer) {
    bf16_t* HQ = c.ws<bf16_t>(WS_HB); const bf16_t* Y = c.ws<bf16_t>(WS_BIG);
    const float* resf = c.in(I_X); const bf16_t* resb = resid_buf(c, 1); bf16_t* XO = resid_buf(c, layer == 0 ? 0 : 2);
    const float* g = c.in(I_LNG) + (layer * 2 + 0) * D; const float* b = c.in(I_LNB) + (layer * 2 + 0) * D;
    for (int row0 = (c.bid * 8 + c.wave) * 2; row0 < NTOK; row0 += c.G * 8 * 2) {
        const float* mod = c.ws<float>(WS_MOD) + (layer * 2 + row0 / SEQ) * 6144;
        float v[2][16];
#pragma unroll
        for (int q = 0; q < 2; ++q)
#pragma unroll
            for (int m = 0; m < 4; ++m) { const int col = 256 * m + 4 * c.lane; const f32x4 g1 = *(const f32x4*)(mod + 2 * 1024 + col);
                f32x4 t;
                if (layer == 0) t = *(const f32x4*)(resf + (size_t)(row0 + q) * D + col);
                else { const u32x2 tb = *(const u32x2*)(resb + (size_t)(row0 + q) * D + col); t = (f32x4){bf2f(tb[0]), bf2f(tb[0] >> 16), bf2f(tb[1]), bf2f(tb[1] >> 16)}; }
                const u32x2 yy = *(const u32x2*)(Y + (size_t)(row0 + q) * D + col);
                v[q][4 * m] = DN_ALPHA * t[0] + g1[0] * bf2f(yy[0]); v[q][4 * m + 1] = DN_ALPHA * t[1] + g1[1] * bf2f(yy[0] >> 16);
                v[q][4 * m + 2] = DN_ALPHA * t[2] + g1[2] * bf2f(yy[1]); v[q][4 * m + 3] = DN_ALPHA * t[3] + g1[3] * bf2f(yy[1] >> 16); }
#pragma unroll
        for (int q = 0; q < 2; ++q) {
            ln_row(v[q], g, b, c.lane);
#pragma unroll
            for (int m = 0; m < 4; ++m) *(u32x2*)(XO + (size_t)(row0 + q) * D + 256 * m + 4 * c.lane) = (u32x2){pk2(v[q][4 * m], v[q][4 * m + 1]), pk2(v[q][4 * m + 2], v[q][4 * m + 3])};
            store_mod_bf16(v[q], HQ + (size_t)(row0 + q) * D, mod + 3 * 1024, mod + 4 * 1024, c.lane);
        }
    }
}

__device__ __forceinline__ void ce_desc(unsigned& a, unsigned& b) { const unsigned hi = a > b ? a : b, lo = a > b ? b : a; a = hi; b = lo; }
__device__ __forceinline__ void sort16_desc(unsigned (&v)[16]) {
#pragma unroll
    for (int k = 2; k <= 16; k <<= 1)
#pragma unroll
        for (int j = k >> 1; j > 0; j >>= 1)
#pragma unroll
            for (int i = 0; i < 16; ++i) { const int l = i ^ j; if (l > i) { if ((i & k) == 0) ce_desc(v[i], v[l]); else ce_desc(v[l], v[i]); } }
}
__device__ __forceinline__ void bitonic_merge16_desc(unsigned (&v)[16]) {
#pragma unroll
    for (int j = 8; j > 0; j >>= 1)
#pragma unroll
        for (int i = 0; i < 16; ++i) { const int l = i ^ j; if (l > i) ce_desc(v[i], v[l]); }
}
__device__ __forceinline__ void merge_top16(unsigned (&L)[16], unsigned (&C)[16]) {
    sort16_desc(C);
#pragma unroll
    for (int i = 0; i < 16; ++i) L[i] = L[i] > C[15 - i] ? L[i] : C[15 - i];
    bitonic_merge16_desc(L);
}
__device__ __forceinline__ unsigned f32_sortable(float f) { const unsigned u = __builtin_bit_cast(unsigned, f); return u ^ ((u >> 31) ? 0xFFFFFFFFu : 0x80000000u); }
__device__ void phase_topk(const Ctx& c) {
    const _Float16* S = c.ws<_Float16>(WS_BIG);
    unsigned short* IDX = c.ws<unsigned short>(WS_IDX);
    float* GATE = c.ws<float>(WS_GATE);
    LAS unsigned char* wl = c.lds + c.wave * 17408;
    LAS unsigned char* ib = c.lds + 139264 + c.tid * 32;
    const int lane = c.lane;
    for (int blk = c.bid; blk < NTOK * 8 / NT; blk += c.G) {
        const int it0 = blk * NT + c.wave * 64;
        float val[2][16];
#pragma unroll
        for (int part = 0; part < 2; ++part) {
#pragma unroll
            for (int i = 0; i < 16; ++i) { const int row = i * 4 + (lane >> 4), ch = lane & 15, item = it0 + row;
                const u32x4 v = *(const u32x4*)(S + (size_t)(item >> 3) * PQN + (item & 7) * 256 + part * 128 + ch * 8);
                *(LAS u32x4*)(wl + row * 272 + ch * 16) = v; }
            unsigned L[16];
#pragma unroll 1
            for (int q = 0; q < 8; ++q) {
                const u32x4 w0 = *(const LAS u32x4*)(wl + lane * 272 + q * 32), w1 = *(const LAS u32x4*)(wl + lane * 272 + q * 32 + 16);
                const unsigned w[8] = {w0.x, w0.y, w0.z, w0.w, w1.x, w1.y, w1.z, w1.w};
                unsigned C[16];
#pragma unroll
                for (int e = 0; e < 16; ++e) { const unsigned hb = (e & 1) ? (w[e >> 1] >> 16) : (w[e >> 1] & 0xffffu);
                    const unsigned sk = hb ^ ((hb & 0x8000u) ? 0xffffu : 0x8000u);
                    C[e] = (sk << 16) | (unsigned)(127 - (q * 16 + e)); }
                if (q == 0) {
#pragma unroll
                    for (int e = 0; e < 16; ++e) L[e] = 0u; }
                merge_top16(L, C);
            }
#pragma unroll
            for (int e = 0; e < 16; ++e) { const unsigned sk = L[e] >> 16, hb = sk ^ ((sk & 0x8000u) ? 0x8000u : 0xffffu);
                val[part][e] = (float)__builtin_bit_cast(_Float16, (unsigned short)hb);
                ib[part * 16 + e] = (unsigned char)(127u - (L[e] & 127u)); }
        }
        unsigned T[16];
#pragma unroll
        for (int j = 0; j < 16; ++j) T[j] = (f32_sortable(val[0][0] + val[1][j]) & 0xffffff00u) | (unsigned)(255 - j);
        {
            unsigned C[16]; int n = 0;
#pragma unroll
            for (int i = 1; i < 16; ++i)
#pragma unroll
                for (int j = 0; j < 16; ++j) if ((i + 1) * (j + 1) <= 16) {
                    const unsigned key = (f32_sortable(val[0][i] + val[1][j]) & 0xffffff00u) | (unsigned)(255 - (16 * i + j));
                    if (n < 32) { C[n & 15] = key; if ((n & 15) == 15) merge_top16(T, C); }
                    else { unsigned x = key;
#pragma unroll
                        for (int k = 0; k < 16; ++k) { const unsigned hi = T[k] > x ? T[k] : x; x = T[k] > x ? x : T[k]; T[k] = hi; } }
                    ++n; }
        }
        float gv[16]; int id[16]; float sum = 0.f, mx;
        { const unsigned sk = T[0] & 0xffffff00u; mx = __builtin_bit_cast(float, (sk & 0x80000000u) ? (sk ^ 0x80000000u) : ~sk); }
#pragma unroll
        for (int k = 0; k < 16; ++k) { const unsigned sk = T[k] & 0xffffff00u, flat = 255u - (T[k] & 255u);
            const float v = __builtin_bit_cast(float, (sk & 0x80000000u) ? (sk ^ 0x80000000u) : ~sk);
            gv[k] = __expf(v - mx); sum += gv[k];
            id[k] = (int)ib[flat >> 4] * 128 + (int)ib[16 + (flat & 15)]; }
        const float inv = 1.0f / sum;
        const size_t o = (size_t)(blk * NT + c.tid) * 16;
#pragma unroll
        for (int q = 0; q < 2; ++q) { u32x4 w; w.x = id[8 * q] | (id[8 * q + 1] << 16); w.y = id[8 * q + 2] | (id[8 * q + 3] << 16); w.z = id[8 * q + 4] | (id[8 * q + 5] << 16); w.w = id[8 * q + 6] | (id[8 * q + 7] << 16);
            *(u32x4*)(IDX + o + 8 * q) = w; }
#pragma unroll
        for (int q = 0; q < 4; ++q) *(f32x4*)(GATE + o + 4 * q) = (f32x4){gv[4 * q] * inv, gv[4 * q + 1] * inv, gv[4 * q + 2] * inv, gv[4 * q + 3] * inv};
    }
}

typedef float v32f __attribute__((ext_vector_type(32)));
typedef unsigned v6u_t __attribute__((ext_vector_type(6)));
typedef unsigned u32x4a8 __attribute__((ext_vector_type(4), aligned(8)));
typedef _Float16 v32h_t __attribute__((ext_vector_type(32)));
typedef _Float16 v2h_t __attribute__((ext_vector_type(2)));
constexpr int NSL = 2;
__device__ void phase_gather_u(const Ctx& c, int layer) {
    const bf16_t* HQ = c.ws<bf16_t>(WS_HB);
    const unsigned short* IDX = c.ws<unsigned short>(WS_IDX);
    float* PART = c.ws<float>(WS_BIG);
    const int lane = c.lane, r16 = lane & 15, g = lane >> 4;
    const int h = (c.bid & 7) >> 2, r = 16 * h + r16;
    const unsigned char* U6 = c.ws<unsigned char>(WS_TAB8) + (size_t)(layer * 2 + 0) * 16384 * 768 + 24 * r;
    const bool b3 = lane & 8, b2 = lane & 4, b1 = lane & 2;
    const int jmine = 4 * (int)b3 + 2 * (int)b2 + (int)b1;
    const int nblk = c.G >> 1, blk = (c.bid >> 3) * 4 + (c.bid & 3);
    const int tstep = nblk * 8;
#define GU_LOAD_TOK(t_, hq_, i0_, i1_) do { const int t__ = (t_) < NTOK ? (t_) : NTOK - 1; \
        _Pragma("unroll") for (int m = 0; m < 8; ++m) hq_[m] = *(const u32x2*)(HQ + (size_t)t__ * D + 128 * m + 4 * r); \
        i0_ = IDX[(size_t)t__ * 128 + lane]; i1_ = IDX[(size_t)t__ * 128 + 64 + lane]; } while (0)
#define GU_ISSUE(i0_, i1_, ch_, a4_, a2_) do { _Pragma("unroll") for (int j = 0; j < 8; ++j) { const int id = lane_geti((ch_) < 2 ? i0_ : i1_, (32 * (ch_) + 4 * j + g) & 63); const unsigned char* up = U6 + __umul24((unsigned)id, 768u); \
        a4_[j] = *(const u32x4a8*)up; a2_[j] = *(const u32x2*)(up + 16); } } while (0)
#define GU_COMPUTE(a4_, a2_, ch_, t_) do { float p[8]; \
        _Pragma("unroll") for (int j = 0; j < 8; ++j) { const v6u_t q = {a4_[j][0], a4_[j][1], a4_[j][2], a4_[j][3], a2_[j][0], a2_[j][1]}; \
            const v32h_t f = __builtin_amdgcn_cvt_scalef32_pk32_f16_fp6(q, 1.0f); float sdot = 0.f;     \
            _Pragma("unroll") for (int i = 0; i < 16; ++i) sdot = __builtin_amdgcn_fdot2((v2h_t){f[2 * i], f[2 * i + 1]}, xh[i], sdot, false); \
            p[j] = sdot; __builtin_amdgcn_sched_barrier(0); } \
        float r2[4], r3[2], r4;     \
        _Pragma("unroll") for (int k = 0; k < 4; ++k) { const float send = b3 ? p[k] : p[k + 4], keep = b3 ? p[k + 4] : p[k]; r2[k] = keep + dppx<0x128>(send); }     \
        _Pragma("unroll") for (int k = 0; k < 2; ++k) { const float send = b2 ? r2[k] : r2[k + 2], keep = b2 ? r2[k + 2] : r2[k]; r3[k] = keep + dppx<0x141>(send); }     \
        { const float send = b1 ? r3[0] : r3[1], keep = b1 ? r3[1] : r3[0]; r4 = keep + dppx<0x4E>(send); }     \
        r4 += dppx<0xB1>(r4);     \
        if ((t_) < NTOK && (lane & 1) == 0) PART[((size_t)(t_) * NSL + h) * 128 + 32 * (ch_) + 4 * jmine + g] = r4; } while (0)
    int tok = blk * 8 + c.wave;
    u32x2 hqc[8], hqn[8]; int ic0, ic1, in0, in1;
    u32x4 ra4[8], rb4[8]; u32x2 ra2[8], rb2[8];
    GU_LOAD_TOK(tok, hqc, ic0, ic1);
    GU_ISSUE(ic0, ic1, 0, ra4, ra2);
#pragma unroll 1
    for (; tok < NTOK; tok += tstep) {
        v2h_t xh[16];
#pragma unroll
        for (int m = 0; m < 8; ++m)
#pragma unroll
            for (int e = 0; e < 2; ++e) xh[2 * m + e] = __builtin_bit_cast(v2h_t, __builtin_amdgcn_cvt_pkrtz(bf2f(hqc[m][e]), bf2f(hqc[m][e] >> 16)));
        GU_LOAD_TOK(tok + tstep, hqn, in0, in1);
        GU_ISSUE(ic0, ic1, 1, rb4, rb2); GU_COMPUTE(ra4, ra2, 0, tok);
        GU_ISSUE(ic0, ic1, 2, ra4, ra2); GU_COMPUTE(rb4, rb2, 1, tok);
        GU_ISSUE(ic0, ic1, 3, rb4, rb2); GU_COMPUTE(ra4, ra2, 2, tok);
        GU_ISSUE(in0, in1, 0, ra4, ra2); GU_COMPUTE(rb4, rb2, 3, tok);
#pragma unroll
        for (int m = 0; m < 8; ++m) hqc[m] = hqn[m];
        ic0 = in0; ic1 = in1;
    }
#undef GU_LOAD_TOK
#undef GU_ISSUE
#undef GU_COMPUTE
}
__device__ void phase_gather_v(const Ctx& c, int layer) {
    float* X = c.a->out; const bf16_t* XI = resid_buf(c, layer == 0 ? 0 : 2); bf16_t* XO = resid_buf(c, 1);
    const unsigned short* IDX = c.ws<unsigned short>(WS_IDX);
    const float* GATE = c.ws<float>(WS_GATE); const float* PART = c.ws<float>(WS_BIG);
    const f32x2* DQ2 = c.ws<f32x2>(WS_DQ) + (size_t)layer * 16384;
    const unsigned char* V6 = c.ws<unsigned char>(WS_TAB8) + (size_t)(layer * 2 + 1) * 16384 * 768;
    const float* g = c.in(I_LNG) + (layer * 2 + 1) * D; const float* b = c.in(I_LNB) + (layer * 2 + 1) * D;
    const int lane = c.lane, hh = lane >> 5, r = lane & 31;
    const unsigned char* V6r = V6 + 24 * r;
    const int tstep = c.G * 8;
#define GV_ISSUE(isel_, wsel_, ch_, a4_, a2_, wj_) do { _Pragma("unroll") for (int j = 0; j < 4; ++j) { const int sl_ = (8 * (ch_) + 2 * j + hh) & 63; const int id = lane_geti(isel_, sl_); \
        { const float wf_ = lane_get(wsel_, sl_); wj_[j] = __builtin_bit_cast(v2h_t, __builtin_amdgcn_cvt_pkrtz(wf_, wf_)); } \
        const unsigned char* vp = V6r + __umul24((unsigned)id, 768u); a4_[j] = *(const u32x4a8*)vp; a2_[j] = *(const u32x2*)(vp + 16); } } while (0)
#define GV_COMPUTE(a4_, a2_, wj_) do { _Pragma("unroll") for (int j = 0; j < 4; ++j) { const v6u_t wv = {a4_[j][0], a4_[j][1], a4_[j][2], a4_[j][3], a2_[j][0], a2_[j][1]}; \
        const v32h_t f = __builtin_amdgcn_cvt_scalef32_pk32_f16_fp6(wv, 1.0f);     \
        _Pragma("unroll") for (int i = 0; i < 16; ++i) acc2[i] = __builtin_elementwise_fma((v2h_t){f[2 * i], f[2 * i + 1]}, wj_[j], acc2[i]);     \
        __builtin_amdgcn_sched_barrier(0); } } while (0)
#define GV_PAIR(cp_) do { { const int ch_ = 2 * (cp_) + 1; GV_ISSUE((ch_ < 8 ? id0 : id1), (ch_ < 8 ? w0 : w1), ch_, rb4, rb2, wb); } \
        GV_COMPUTE(ra4, ra2, wa); \
        { const int ch_ = (2 * (cp_) + 2) & 15; const bool nx_ = (cp_) == 7; GV_ISSUE((nx_ ? idn0 : (ch_ < 8 ? id0 : id1)), (nx_ ? wn0 : (ch_ < 8 ? w0 : w1)), ch_, ra4, ra2, wa); } \
        GV_COMPUTE(rb4, rb2, wb); } while (0)
#define GV_WEIGHTS(t_, i0_, i1_, o0_, o1_) do { const f32x2 dq0 = DQ2[i0_], dq1 = DQ2[i1_]; const float g0 = GATE[(size_t)(t_) * 128 + lane], g1 = GATE[(size_t)(t_) * 128 + 64 + lane]; \
        float s0 = 0.f, s1 = 0.f; \
        _Pragma("unroll") for (int sl = 0; sl < NSL; ++sl) { s0 += PART[((size_t)(t_) * NSL + sl) * 128 + lane]; s1 += PART[((size_t)(t_) * NSL + sl) * 128 + 64 + lane]; } \
        o0_ = gelu_erf(s0 * dq0[0]) * (g0 * dq0[1]); o1_ = gelu_erf(s1 * dq1[0]) * (g1 * dq1[1]); } while (0)
#define GV_NORM(o0_, o1_, mx_) do { mx_ = wave_max(fmaxf(fabsf(o0_), fabsf(o1_)), lane); const float inv_ = mx_ > 0.f ? 1.0f / mx_ : 0.f; o0_ *= inv_; o1_ *= inv_; } while (0)
    int tok = c.bid * 8 + c.wave;
    int id0 = 0, id1 = 0, idn0, idn1; float w0 = 0.f, w1 = 0.f, wn0, wn1;
    u32x4 ra4[4], rb4[4]; u32x2 ra2[4], rb2[4]; v2h_t wa[4], wb[4]; float wmax = 0.f, wmaxn;
    if (tok < NTOK) { id0 = IDX[(size_t)tok * 128 + lane]; id1 = IDX[(size_t)tok * 128 + 64 + lane]; GV_WEIGHTS(tok, id0, id1, w0, w1); GV_NORM(w0, w1, wmax); }
    GV_ISSUE(id0, w0, 0, ra4, ra2, wa);
#pragma unroll 1
    for (; tok < NTOK; tok += tstep) {
        const int bt = tok / SEQ;
        const float* mod = c.ws<float>(WS_MOD) + (layer * 2 + bt) * 6144;
        const int tn = tok + tstep < NTOK ? tok + tstep : tok;
        v2h_t acc2[16];
#pragma unroll
        for (int i = 0; i < 16; ++i) acc2[i] = (v2h_t){(_Float16)0.f, (_Float16)0.f};
        idn0 = IDX[(size_t)tn * 128 + lane]; idn1 = IDX[(size_t)tn * 128 + 64 + lane];
        const float gn0 = GATE[(size_t)tn * 128 + lane], gn1 = GATE[(size_t)tn * 128 + 64 + lane];
        float sn0 = 0.f, sn1 = 0.f; float pn[2 * NSL];
#pragma unroll
        for (int sl = 0; sl < NSL; ++sl) { pn[2 * sl] = PART[((size_t)tn * NSL + sl) * 128 + lane]; pn[2 * sl + 1] = PART[((size_t)tn * NSL + sl) * 128 + 64 + lane]; }
#pragma unroll 1
        for (int cp = 0; cp < 2; ++cp) GV_PAIR(cp);
        const f32x2 dqn0 = DQ2[idn0], dqn1 = DQ2[idn1];
#pragma unroll 1
        for (int cp = 2; cp < 6; ++cp) GV_PAIR(cp);
#pragma unroll
        for (int sl = 0; sl < NSL; ++sl) { sn0 += pn[2 * sl]; sn1 += pn[2 * sl + 1]; }
        wn0 = gelu_erf(sn0 * dqn0[0]) * (gn0 * dqn0[1]); wn1 = gelu_erf(sn1 * dqn1[0]) * (gn1 * dqn1[1]); GV_NORM(wn0, wn1, wmaxn);
        f32x4 x1v[4], g2v[4];
#pragma unroll
        for (int m = 0; m < 4; ++m) { const int col = 128 * (4 * hh + m) + 4 * r; { const u32x2 tb = *(const u32x2*)(XI + (size_t)tok * D + col); x1v[m] = (f32x4){bf2f(tb[0]), bf2f(tb[0] >> 16), bf2f(tb[1]), bf2f(tb[1] >> 16)}; } g2v[m] = *(const f32x4*)(mod + 5 * 1024 + col); }
#pragma unroll 1
        for (int cp = 6; cp < 8; ++cp) GV_PAIR(cp);
        float y[16];
#pragma unroll
        for (int k = 0; k < 8; ++k) { const v2h_t send = hh ? acc2[k] : acc2[8 + k], keep = hh ? acc2[8 + k] : acc2[k];
            const v2h_t got = __builtin_bit_cast(v2h_t, lane_geti(__builtin_bit_cast(int, send), lane ^ 32));
            y[2 * k] = ((float)keep[0] + (float)got[0]) * wmax; y[2 * k + 1] = ((float)keep[1] + (float)got[1]) * wmax; }
#pragma unroll
        for (int m = 0; m < 4; ++m) { const f32x4 g2 = g2v[m], x1 = x1v[m];
#pragma unroll
            for (int e = 0; e < 4; ++e) y[4 * m + e] = DN_ALPHA * x1[e] + g2[e] * y[4 * m + e]; }
        ln_row<3>(y, g, b, lane);
        if (layer == 0) {
#pragma unroll
            for (int m = 0; m < 4; ++m) *(u32x2*)(XO + (size_t)tok * D + 128 * (4 * hh + m) + 4 * r) = (u32x2){pk2(y[4 * m], y[4 * m + 1]), pk2(y[4 * m + 2], y[4 * m + 3])};
        } else {
#pragma unroll
            for (int m = 0; m < 4; ++m) *(f32x4*)(X + (size_t)tok * D + 128 * (4 * hh + m) + 4 * r) = (f32x4){y[4 * m], y[4 * m + 1], y[4 * m + 2], y[4 * m + 3]};
        }
        if (layer == 0) { const float* mod1 = c.ws<float>(WS_MOD) + (2 + bt) * 6144; store_mod_bf16<3>(y, c.ws<bf16_t>(WS_MIX) + (size_t)tok * D, mod1, mod1 + 1024, lane); }
        id0 = idn0; id1 = idn1; w0 = wn0; w1 = wn1; wmax = wmaxn;
    }
#undef GV_ISSUE
#undef GV_COMPUTE
#undef GV_PAIR
#undef GV_WEIGHTS
#undef GV_NORM
}

typedef unsigned cf;
struct cs { float x, y; };
__device__ __forceinline__ cs smul(cs a, cs b) { return cs{a.x * b.x - a.y * b.y, a.x * b.y + a.y * b.x}; }
__device__ __forceinline__ cs smulc(cs a, cs b) { return cs{a.x * b.x + a.y * b.y, a.y * b.x - a.x * b.y}; }
__device__ __forceinline__ cf cpack(float re, float im) { cf r; asm("v_cvt_pk_f16_f32 %0, %1, %2" : "=v"(r) : "v"(re), "v"(im)); return r; }
__device__ __forceinline__ cs cunpack(cf v) { typedef _Float16 h2 __attribute__((ext_vector_type(2))); const h2 h = __builtin_bit_cast(h2, v); return cs{(float)h[0], (float)h[1]}; }
__device__ __forceinline__ cf cmul(cf a, cf b) { cf t, r;
    asm("v_pk_mul_f16 %0, %1, %2 op_sel:[1,1] op_sel_hi:[1,0]" : "=v"(t) : "v"(a), "v"(b));
    asm("v_pk_fma_f16 %0, %1, %2, %3 op_sel:[0,0,0] op_sel_hi:[0,1,1] neg_lo:[0,0,1]" : "=v"(r) : "v"(a), "v"(b), "v"(t)); return r; }
__device__ __forceinline__ cf cmulc(cf a, cf b) { cf t, r;
    asm("v_pk_mul_f16 %0, %1, %2 op_sel:[1,1] op_sel_hi:[0,1]" : "=v"(t) : "v"(a), "v"(b));
    asm("v_pk_fma_f16 %0, %1, %2, %3 op_sel:[0,0,0] op_sel_hi:[1,0,1] neg_hi:[0,0,1]" : "=v"(r) : "v"(a), "v"(b), "v"(t)); return r; }
__device__ __forceinline__ cf cmul_k(cf a, cf b) { cf t, r;
    asm("v_pk_mul_f16 %0, %1, %2 op_sel:[1,1] op_sel_hi:[1,0]" : "=v"(t) : "v"(a), "s"(b));
    asm("v_pk_fma_f16 %0, %1, %2, %3 op_sel:[0,0,0] op_sel_hi:[0,1,1] neg_lo:[0,0,1]" : "=v"(r) : "v"(a), "s"(b), "v"(t)); return r; }
__device__ __forceinline__ cf cmulc_k(cf a, cf b) { cf t, r;
    asm("v_pk_mul_f16 %0, %1, %2 op_sel:[1,1] op_sel_hi:[0,1]" : "=v"(t) : "v"(a), "s"(b));
    asm("v_pk_fma_f16 %0, %1, %2, %3 op_sel:[0,0,0] op_sel_hi:[1,0,1] neg_hi:[0,0,1]" : "=v"(r) : "v"(a), "s"(b), "v"(t)); return r; }
__device__ __forceinline__ cf cscale(cf a, cf s2) { cf r; asm("v_pk_mul_f16 %0, %1, %2" : "=v"(r) : "v"(a), "v"(s2)); return r; }
__device__ __forceinline__ cf cadd(cf a, cf b) { cf r; asm("v_pk_add_f16 %0, %1, %2" : "=v"(r) : "v"(a), "v"(b)); return r; }
__device__ __forceinline__ cf csub(cf a, cf b) { cf r; asm("v_pk_add_f16 %0, %1, %2 neg_lo:[0,1] neg_hi:[0,1]" : "=v"(r) : "v"(a), "v"(b)); return r; }
__device__ __forceinline__ cf cadd_mi(cf a, cf b) { cf r; asm("v_pk_add_f16 %0, %1, %2 op_sel:[0,1] op_sel_hi:[1,0] neg_hi:[0,1]" : "=v"(r) : "v"(a), "v"(b)); return r; }
__device__ __forceinline__ cf cadd_pi(cf a, cf b) { cf r; asm("v_pk_add_f16 %0, %1, %2 op_sel:[0,1] op_sel_hi:[1,0] neg_lo:[0,1]" : "=v"(r) : "v"(a), "v"(b)); return r; }
template <bool INV> __device__ __forceinline__ void dft4(cf& a0, cf& a1, cf& a2, cf& a3) {
    const cf s02 = cadd(a0, a2), d02 = csub(a0, a2), s13 = cadd(a1, a3), d13 = csub(a1, a3);
    a0 = cadd(s02, s13); a2 = csub(s02, s13);
    a1 = INV ? cadd_pi(d02, d13) : cadd_mi(d02, d13); a3 = INV ? cadd_mi(d02, d13) : cadd_pi(d02, d13);
}
__device__ __forceinline__ constexpr cf cconst(float re, float im) { typedef _Float16 h2 __attribute__((ext_vector_type(2))); return __builtin_bit_cast(unsigned, (h2){(_Float16)re, (_Float16)im}); }
template <bool INV> __device__ __forceinline__ cf w16(cf a, int m) {
    const float c1 = 0.92387953251128674f, s1 = 0.38268343236508977f, r = 0.70710678118654752f;
    cf w;
    switch (m) { case 0: return a; case 1: w = cconst(c1, -s1); break; case 2: w = cconst(r, -r); break; case 3: w = cconst(s1, -c1); break; case 4: w = cconst(0.f, -1.f); break; case 6: w = cconst(-r, -r); break; default: w = cconst(-c1, s1); break; }
    return INV ? cmulc_k(a, w) : cmul_k(a, w);
}
template <bool INV> __device__ __forceinline__ void dft16(cf (&v)[16]) {
#pragma unroll
    for (int b = 0; b < 4; ++b) dft4<INV>(v[b], v[4 + b], v[8 + b], v[12 + b]);
#pragma unroll
    for (int k1 = 1; k1 < 4; ++k1)
#pragma unroll
        for (int b = 1; b < 4; ++b) v[4 * k1 + b] = w16<INV>(v[4 * k1 + b], b * k1);
#pragma unroll
    for (int k1 = 0; k1 < 4; ++k1) dft4<INV>(v[4 * k1], v[4 * k1 + 1], v[4 * k1 + 2], v[4 * k1 + 3]);
}
__device__ __forceinline__ int fpad(int p) { return p + ((p >> 6) << 2); }
typedef LAS unsigned* cbuf_t;
__device__ __forceinline__ cf ldc(cbuf_t b, int i) { return b[i]; }
__device__ __forceinline__ void stc(cbuf_t b, int i, cf v) { b[i] = v; }
__device__ __forceinline__ void wpowers(cf w, cf (&p)[16]) {
    p[1] = w; p[2] = cmul(w, w); p[3] = cmul(p[2], w); p[4] = cmul(p[2], p[2]); p[5] = cmul(p[4], w); p[6] = cmul(p[3], p[3]); p[7] = cmul(p[4], p[3]);
    p[8] = cmul(p[4], p[4]); p[9] = cmul(p[8], w); p[10] = cmul(p[5], p[5]); p[11] = cmul(p[8], p[3]); p[12] = cmul(p[6], p[6]); p[13] = cmul(p[8], p[5]); p[14] = cmul(p[7], p[7]); p[15] = cmul(p[8], p[7]);
}
template <bool INV, int PS> __device__ __forceinline__ void fft_stage16(cbuf_t buf, int pb, cf w) {
    cf v[16], p[16];
#pragma unroll
    for (int j = 0; j < 16; ++j) v[j] = ldc(buf, pb + j * PS);
    wpowers(w, p);
    if (INV) {
#pragma unroll
        for (int k = 1; k < 16; ++k) v[k] = cmulc(v[k], p[k]);
    }
    dft16<INV>(v);
    if (!INV) {
#pragma unroll
        for (int k = 1; k < 16; ++k) { const int r = 4 * (k & 3) + (k >> 2); v[r] = cmul(v[r], p[k]); }
    }
#pragma unroll
    for (int k = 0; k < 16; ++k) stc(buf, pb + k * PS, v[4 * (k & 3) + (k >> 2)]);
}
__device__ __forceinline__ cf ldtw(const f32x2* t, int i) { const f32x2 v = t[i]; return cpack(v[0], v[1]); }

__device__ __forceinline__ void fft_fwd_to_regs(cbuf_t buf, int tid, const f32x2* tws, unsigned (&K)[32], float sc) {
#pragma unroll
    for (int rep = 0; rep < 2; ++rep) { const int id = tid + NT * rep; fft_stage16<false, 1088>(buf, fpad(id), ldtw(tws, id)); }
    __syncthreads();
#pragma unroll
    for (int rep = 0; rep < 2; ++rep) { const int id = tid + NT * rep; fft_stage16<false, 68>(buf, fpad((id >> 6) * 1024 + (id & 63)), ldtw(tws + 1024, id & 63)); }
    __syncthreads();
#pragma unroll
    for (int rep = 0; rep < 2; ++rep) { const int id = tid + NT * rep; fft_stage16<false, 4>(buf, fpad((id >> 2) * 64 + (id & 3)), ldtw(tws + 1088, id & 3)); }
    __syncthreads();
    const cf scv = cpack(sc, sc);
#pragma unroll
    for (int rep = 0; rep < 8; ++rep) { const int base = fpad(4 * (tid + NT * rep));
        cf a0 = ldc(buf, base), a1 = ldc(buf, base + 1), a2 = ldc(buf, base + 2), a3 = ldc(buf, base + 3);
        dft4<false>(a0, a1, a2, a3);
        K[4 * rep] = cscale(a0, scv); K[4 * rep + 1] = cscale(a1, scv); K[4 * rep + 2] = cscale(a2, scv); K[4 * rep + 3] = cscale(a3, scv); }
    __syncthreads();
}
__device__ __forceinline__ void fft_conv_with_regs(cbuf_t buf, int tid, const f32x2* tws, const unsigned (&K)[32]) {
#pragma unroll
    for (int rep = 0; rep < 2; ++rep) { const int id = tid + NT * rep; fft_stage16<false, 1088>(buf, fpad(id), ldtw(tws, id)); }
    __syncthreads();
#pragma unroll
    for (int rep = 0; rep < 2; ++rep) { const int id = tid + NT * rep; fft_stage16<false, 68>(buf, fpad((id >> 6) * 1024 + (id & 63)), ldtw(tws + 1024, id & 63)); }
    __syncthreads();
#pragma unroll
    for (int rep = 0; rep < 2; ++rep) { const int id = tid + NT * rep; fft_stage16<false, 4>(buf, fpad((id >> 2) * 64 + (id & 3)), ldtw(tws + 1088, id & 3)); }
    __syncthreads();
#pragma unroll
    for (int rep = 0; rep < 8; ++rep) { const int base = fpad(4 * (tid + NT * rep));
        cf a0 = ldc(buf, base), a1 = ldc(buf, base + 1), a2 = ldc(buf, base + 2), a3 = ldc(buf, base + 3);
        dft4<false>(a0, a1, a2, a3);
        a0 = cmul(a0, K[4 * rep]); a1 = cmul(a1, K[4 * rep + 1]); a2 = cmul(a2, K[4 * rep + 2]); a3 = cmul(a3, K[4 * rep + 3]);
        dft4<true>(a0, a1, a2, a3);
        stc(buf, base, a0); stc(buf, base + 1, a1); stc(buf, base + 2, a2); stc(buf, base + 3, a3); }
    __syncthreads();
#pragma unroll
    for (int rep = 0; rep < 2; ++rep) { const int id = tid + NT * rep; fft_stage16<true, 4>(buf, fpad((id >> 2) * 64 + (id & 3)), ldtw(tws + 1088, id & 3)); }
    __syncthreads();
#pragma unroll
    for (int rep = 0; rep < 2; ++rep) { const int id = tid + NT * rep; fft_stage16<true, 68>(buf, fpad((id >> 6) * 1024 + (id & 63)), ldtw(tws + 1024, id & 63)); }
    __syncthreads();
#pragma unroll
    for (int rep = 0; rep < 2; ++rep) { const int id = tid + NT * rep; fft_stage16<true, 1088>(buf, fpad(id), ldtw(tws, id)); }
    __syncthreads();
}

__device__ __forceinline__ void sconv8(const bf16_t* row, int t0, float w0, float w1, float w2, float cb, float (&o)[8]) {
    const u32x4 m = *(const u32x4*)(row + t0);
    const unsigned lraw = *(const unsigned*)(row + (t0 > 0 ? t0 - 2 : 0));
    const unsigned rraw = *(const unsigned*)(row + (t0 + 8 < SEQ ? t0 + 8 : SEQ - 2));
    const unsigned l = t0 > 0 ? lraw : 0u, r = t0 + 8 < SEQ ? rraw : 0u;
    float x[10];
    x[0] = bf2f(l >> 16); x[9] = bf2f(r);
#pragma unroll
    for (int k = 0; k < 4; ++k) { x[1 + 2 * k] = bf2f(m[k]); x[2 + 2 * k] = bf2f(m[k] >> 16); }
#pragma unroll
    for (int k = 0; k < 8; ++k) o[k] = w0 * x[k] + w1 * x[k + 1] + w2 * x[k + 2] + cb;
}
__device__ __forceinline__ void unpack8(const u32x4 m, float (&x)[8]) {
#pragma unroll
    for (int k = 0; k < 4; ++k) { x[2 * k] = bf2f(m[k]); x[2 * k + 1] = bf2f(m[k] >> 16); }
}
__device__ void phase_hyena_conv(const Ctx& c) {
    cbuf_t buf = (cbuf_t)c.lds;
    LAS float* red = (LAS float*)(c.lds + 139264);
    const bf16_t* ZT = c.ws<bf16_t>(WS_BIG);
    bf16_t* YT = c.ws<bf16_t>(WS_MIX);
    const bf16_t* FILT = c.ws<bf16_t>(WS_FILT);
    const f32x2* tws = c.ws<f32x2>(WS_TWS);
    const f32x2* twodd = c.ws<f32x2>(WS_TWODD);
    unsigned* scr_vv = c.ws<unsigned>(WS_HB) + (size_t)c.bid * 2 * SEQ;
    unsigned* scr_re = scr_vv + SEQ;
    const float* CW = c.in(I_HYCW); const float* CB = c.in(I_HYCB);
    const int tid = c.tid;
    const int rot = c.bid & 3;
    constexpr float FS = 1.0f / 16.0f, ZS = 1.0f / 256.0f;
    LAS unsigned* twl = (LAS unsigned*)(c.lds + 69632);
    __syncthreads();
    for (int e = tid; e < SEQ; e += NT) { const f32x2 w = twodd[e]; twl[e] = cpack(w[0], w[1]); }
#define TWL8(t0, wa, wb) const u32x4 wa = *(const LAS u32x4*)(twl + (t0)), wb = *(const LAS u32x4*)(twl + (t0) + 4)
#define TWJ(wa, wb, j) cunpack((j) < 4 ? wa[(j) & 3] : wb[(j) & 3])
#define T8(m) (8 * (tid + NT * (((m) + rot) & 3)))
#define LDSQ(t0, k) (*(LAS u32x2*)(buf + fpad((t0) + 2 * (k))))
    for (int ch = c.bid; ch < 1024; ch += c.G) {
        const bf16_t* fw = FILT + (size_t)ch * SEQ; const bf16_t* bw = FILT + (size_t)(1024 + ch) * SEQ;
        unsigned K[32];
        __syncthreads();
        float l1p = 0.f;
#pragma unroll
        for (int m = 0; m < 4; ++m) { const int t0 = T8(m); float f[8], b[8]; unpack8(*(const u32x4*)(fw + t0), f); unpack8(*(const u32x4*)(bw + t0), b);
#pragma unroll
            for (int k = 0; k < 4; ++k) { l1p += (fabsf(f[2 * k]) + fabsf(b[2 * k])) + (fabsf(f[2 * k + 1]) + fabsf(b[2 * k + 1])); LDSQ(t0, k) = (u32x2){cpack((f[2 * k] + b[2 * k]) * FS, 0.f), cpack((f[2 * k + 1] + b[2 * k + 1]) * FS, 0.f)}; } }
        l1p = wave_sum(l1p, c.lane);
        if (c.lane == 0) red[c.wave] = l1p;
        __syncthreads();
        float l1 = 0.f;
#pragma unroll
        for (int w = 0; w < 8; ++w) l1 += red[w];
        const float il1 = 1.0f / l1, ksc = il1 * (1.0f / FS);
        fft_fwd_to_regs(buf, tid, tws, K, ksc);
        {
            const float wx0 = CW[0 * HY3 + 1024 + ch], wx1 = CW[1 * HY3 + 1024 + ch], wx2 = CW[2 * HY3 + 1024 + ch], cbx = CB[1024 + ch];
            const float wv0 = CW[0 * HY3 + 2048 + ch], wv1 = CW[1 * HY3 + 2048 + ch], wv2 = CW[2 * HY3 + 2048 + ch], cbv = CB[2048 + ch];
            const bf16_t* x1r = ZT + (size_t)(1024 + ch) * NTOK; const bf16_t* vr = ZT + (size_t)(2048 + ch) * NTOK;
#pragma unroll 2
            for (int m = 0; m < 4; ++m) { const int t0 = T8(m);
                float va[8], xa[8], vb[8], xb[8];
                sconv8(vr, t0, wv0, wv1, wv2, cbv, va); sconv8(x1r, t0, wx0, wx1, wx2, cbx, xa);
                sconv8(vr + SEQ, t0, wv0, wv1, wv2, cbv, vb); sconv8(x1r + SEQ, t0, wx0, wx1, wx2, cbx, xb);
                u32x4 pv[2];
#pragma unroll
                for (int k = 0; k < 4; ++k) { const f32x4 z = (f32x4){va[2 * k] * xa[2 * k], vb[2 * k] * xb[2 * k], va[2 * k + 1] * xa[2 * k + 1], vb[2 * k + 1] * xb[2 * k + 1]};
                    pv[k >> 1][2 * (k & 1)] = pk2(z[0], z[1]); pv[k >> 1][2 * (k & 1) + 1] = pk2(z[2], z[3]); LDSQ(t0, k) = (u32x2){cpack(z[0] * ZS, z[1] * ZS), cpack(z[2] * ZS, z[3] * ZS)}; }
                *(u32x4*)(scr_vv + t0) = pv[0]; *(u32x4*)(scr_vv + t0 + 4) = pv[1]; }
        }
        __syncthreads();
        fft_conv_with_regs(buf, tid, tws, K);
#pragma unroll 2
        for (int m = 0; m < 4; ++m) { const int t0 = T8(m); float f[8], b[8]; unpack8(*(const u32x4*)(fw + t0), f); unpack8(*(const u32x4*)(bw + t0), b);
            u32x4 pr[2]; TWL8(t0, twa, twb);
#pragma unroll
            for (int k = 0; k < 4; ++k) { const cs w0_ = TWJ(twa, twb, 2 * k), w1_ = TWJ(twa, twb, 2 * k + 1); const f32x4 w = (f32x4){w0_.x, w0_.y, w1_.x, w1_.y};
                { const u32x2 rq = LDSQ(t0, k); const cs r0 = cunpack(rq[0]), r1 = cunpack(rq[1]); pr[k >> 1][2 * (k & 1)] = pk2(r0.x, r0.y); pr[k >> 1][2 * (k & 1) + 1] = pk2(r1.x, r1.y); }
                const float d0 = (f[2 * k] - b[2 * k]) * FS, d1 = (f[2 * k + 1] - b[2 * k + 1]) * FS;
                LDSQ(t0, k) = (u32x2){cpack(d0 * w[0], d0 * w[1]), cpack(d1 * w[2], d1 * w[3])}; }
            *(u32x4*)(scr_re + t0) = pr[0]; *(u32x4*)(scr_re + t0 + 4) = pr[1]; }
        __syncthreads();
        fft_fwd_to_regs(buf, tid, tws, K, ksc);
#pragma unroll 2
        for (int m = 0; m < 4; ++m) { const int t0 = T8(m);
            const u32x4 pv0 = *(const u32x4*)(scr_vv + t0), pv1 = *(const u32x4*)(scr_vv + t0 + 4); TWL8(t0, twa, twb);
#pragma unroll
            for (int k = 0; k < 4; ++k) { const unsigned u0 = k < 2 ? pv0[2 * k] : pv1[2 * k - 4], u1 = k < 2 ? pv0[2 * k + 1] : pv1[2 * k - 3]; const cs w0_ = TWJ(twa, twb, 2 * k), w1_ = TWJ(twa, twb, 2 * k + 1); const f32x4 w = (f32x4){w0_.x, w0_.y, w1_.x, w1_.y};
                const cs a = smul(cs{bf2f(u0) * ZS, bf2f(u0 >> 16) * ZS}, cs{w[0], w[1]}), b = smul(cs{bf2f(u1) * ZS, bf2f(u1 >> 16) * ZS}, cs{w[2], w[3]}); LDSQ(t0, k) = (u32x2){cpack(a.x, a.y), cpack(b.x, b.y)}; } }
        __syncthreads();
        fft_conv_with_regs(buf, tid, tws, K);
        {
            const float w00 = CW[0 * HY3 + ch], w01 = CW[1 * HY3 + ch], w02 = CW[2 * HY3 + ch], cb0 = CB[ch];
            const bf16_t* x0r = ZT + (size_t)ch * NTOK;
            const float dsk = c.in(I_HYD)[ch], scale = 0.5f / 16384.0f / ZS;
#pragma unroll 2
            for (int m = 0; m < 4; ++m) { const int t0 = T8(m);
                float xa[8], xb[8]; sconv8(x0r, t0, w00, w01, w02, cb0, xa); sconv8(x0r + SEQ, t0, w00, w01, w02, cb0, xb);
                u32x4 oa, ob;
                const u32x4 pr0 = *(const u32x4*)(scr_re + t0), pr1 = *(const u32x4*)(scr_re + t0 + 4), pv0 = *(const u32x4*)(scr_vv + t0), pv1 = *(const u32x4*)(scr_vv + t0 + 4); TWL8(t0, twa, twb);
#pragma unroll
                for (int k = 0; k < 4; ++k) { const u32x2 rq = LDSQ(t0, k); const cs ro0 = cunpack(rq[0]), ro1 = cunpack(rq[1]); const cs w0_ = TWJ(twa, twb, 2 * k), w1_ = TWJ(twa, twb, 2 * k + 1); const f32x4 w = (f32x4){w0_.x, w0_.y, w1_.x, w1_.y};
                    const unsigned r0 = k < 2 ? pr0[2 * k] : pr1[2 * k - 4], r1 = k < 2 ? pr0[2 * k + 1] : pr1[2 * k - 3], v0 = k < 2 ? pv0[2 * k] : pv1[2 * k - 4], v1 = k < 2 ? pv0[2 * k + 1] : pv1[2 * k - 3];
                    const f32x4 re = (f32x4){bf2f(r0), bf2f(r0 >> 16), bf2f(r1), bf2f(r1 >> 16)}, vv = (f32x4){bf2f(v0), bf2f(v0 >> 16), bf2f(v1), bf2f(v1 >> 16)};
                    const cs q0 = smulc(ro0, cs{w[0], w[1]}), q1 = smulc(ro1, cs{w[2], w[3]});
                    const float ya0 = ((re[0] + q0.x) * scale + vv[0] * dsk) * xa[2 * k], yb0 = ((re[1] + q0.y) * scale + vv[1] * dsk) * xb[2 * k];
                    const float ya1 = ((re[2] + q1.x) * scale + vv[2] * dsk) * xa[2 * k + 1], yb1 = ((re[3] + q1.y) * scale + vv[3] * dsk) * xb[2 * k + 1];
                    oa[k] = pk2(ya0, ya1); ob[k] = pk2(yb0, yb1); }
                *(u32x4*)(YT + (size_t)ch * NTOK + t0) = oa; *(u32x4*)(YT + (size_t)ch * NTOK + SEQ + t0) = ob; }
        }
    }
#undef LDSQ
#undef T8
#undef TWL8
#undef TWJ
    __syncthreads();
}

__device__ void phase_transpose_y(const Ctx& c) {
    const bf16_t* YT = c.ws<bf16_t>(WS_MIX); bf16_t* Y = c.ws<bf16_t>(WS_HB);
    LAS bf16_t* t = (LAS bf16_t*)c.lds;
    for (int tile = c.bid; tile < 16 * 512; tile += c.G) {
        const int c0 = (tile & 15) * 64, n0 = (tile >> 4) * 64;
        __syncthreads();
        { const int r = c.tid >> 3, q = c.tid & 7; const u32x4 v = *(const u32x4*)(YT + (size_t)(c0 + r) * NTOK + n0 + q * 8);
          const unsigned w[4] = {v.x, v.y, v.z, v.w};
#pragma unroll
          for (int e = 0; e < 8; ++e) t[(q * 8 + e) * 72 + r] = (bf16_t)((w[e >> 1] >> (16 * (e & 1))) & 0xffffu); }
        __syncthreads();
        { const int n = c.tid >> 3, q = c.tid & 7; *(u32x4*)(Y + (size_t)(n0 + n) * D + c0 + q * 8) = *(const LAS u32x4*)(t + n * 72 + q * 8); }
    }
    __syncthreads();
}

#define XB_TMO      128
#define XB_XCNT(j)  (256  + 64 * (j))
#define XB_XSUB(j)  (1280 + 64 * (j))
#define XB_XGEN(j)  (2304 + 64 * (j))
#define XB_TOP      3328
#define XB_TOPGEN   3392
#define XCD_BAR_WORDS 3456
#define XB_SPIN_CAP (1u << 18)
__device__ __forceinline__ unsigned xb_ld(unsigned* p)              { return __hip_atomic_load(p, __ATOMIC_RELAXED, __HIP_MEMORY_SCOPE_AGENT); }
__device__ __forceinline__ unsigned xb_add(unsigned* p, unsigned v) { return __hip_atomic_fetch_add(p, v, __ATOMIC_RELAXED, __HIP_MEMORY_SCOPE_AGENT); }
__device__ __forceinline__ unsigned xb_xcc_id() { return (unsigned)__builtin_amdgcn_s_getreg((3 << 11) | 20) & 0xFu; }
#define XB_SPIN(cond, bar) do { unsigned _sp = 0; while (cond) { __builtin_amdgcn_s_sleep(1); \
    if ((++_sp & 255u) == 0u) { if (xb_ld(&(bar)[XB_TMO])) break; if (_sp > XB_SPIN_CAP) { atomicAdd(&(bar)[XB_TMO], 1u); break; } } } } while (0)
struct XcdBarrier { unsigned* bar; unsigned x; volatile LAS unsigned* st; };
__device__ __forceinline__ XcdBarrier xcd_barrier_post(unsigned* bar, volatile LAS unsigned* st, int tid) {
    XcdBarrier b; b.bar = bar; b.x = xb_xcc_id(); b.st = st;
    if (tid == 0) (void)xb_add(&bar[XB_XCNT(b.x)], 1u);
    return b;
}
__device__ __forceinline__ void xcd_barrier_complete(unsigned* bar, unsigned x, unsigned& nloc, unsigned& nx) {
    const unsigned G = gridDim.x * gridDim.y * gridDim.z;
    unsigned sum, cnt, mine, sp = 0u;
    for (;;) {
        sum = 0u; cnt = 0u; mine = 0u;
#pragma unroll
        for (unsigned j = 0; j < 16; ++j) { const unsigned c = xb_ld(&bar[XB_XCNT(j)]); sum += c; cnt += (c > 0u) ? 1u : 0u; mine = (j == x) ? c : mine; }
        if (sum == G) break;
        __builtin_amdgcn_s_sleep(1);
        if ((++sp & 255u) == 0u) { if (xb_ld(&bar[XB_TMO])) break; if (sp > XB_SPIN_CAP) { atomicAdd(&bar[XB_TMO], 1u); break; } }
    }
    nloc = mine > 0u ? mine : 1u; nx = cnt > 0u ? cnt : 1u;
}
__device__ __forceinline__ void xcd_barrier(const XcdBarrier& b, int tid) {
    asm volatile("s_waitcnt vmcnt(0)" ::: "memory");
    __syncthreads();
    if (tid == 0) {
        unsigned* bar = b.bar;
        __builtin_amdgcn_s_waitcnt(0);
        unsigned nloc = b.st[0], nx = b.st[1];
        if (nloc == 0u) { xcd_barrier_complete(bar, b.x, nloc, nx); b.st[0] = nloc; b.st[1] = nx; }
        const unsigned old = xb_add(&bar[XB_XSUB(b.x)], 1u);
        const unsigned gen = old / nloc;
        if (old + 1u == (gen + 1u) * nloc) {
            __builtin_amdgcn_fence(__ATOMIC_RELEASE, "agent");
            asm volatile("s_waitcnt vmcnt(0)" ::: "memory");
            const unsigned og = xb_add(&bar[XB_TOP], 1u);
            const unsigned tg = og / nx;
            if (og + 1u == (tg + 1u) * nx) xb_add(&bar[XB_TOPGEN], 1u);
            else XB_SPIN(xb_ld(&bar[XB_TOPGEN]) == tg, bar);
            __builtin_amdgcn_fence(__ATOMIC_ACQUIRE, "agent");
            xb_add(&bar[XB_XGEN(b.x)], 1u);
            asm volatile("s_waitcnt vmcnt(0)" ::: "memory");
        } else {
            XB_SPIN(xb_ld(&bar[XB_XGEN(b.x)]) == gen, bar);
            __builtin_amdgcn_fence(__ATOMIC_ACQUIRE, "agent");
            asm volatile("s_waitcnt vmcnt(0)" ::: "memory");
        }
    }
    __syncthreads();
}

constexpr int NPH = 19;
template <int P> __device__ __forceinline__ void run_phase(const Ctx& c) {
    const Args& args = *c.a;
    if constexpr (P == 0) phase_prep(c);
    if constexpr (P == 1) phase_mod0_filt(c);
    if constexpr (P == 2) {
        { pg8::Gemm g{c.ws<bf16_t>(WS_HB), c.ws<bf16_t>(WS_WIN_T), NTOK, ABIN, D}; pg8::StaticOrder S; S.init(NTOK, ABIN, c.G, c.bid);
          pg8::EpiBf16 E{c.ws<bf16_t>(WS_BIG), ABIN, 6, nullptr}; pg8::gemm_phase<decltype(E), pg8::StaticOrder, true, true>(c.lds, g, S, E, c.tid); }
        { pg8::Gemm g{c.ws<bf16_t>(WS_HCTX), c.ws<bf16_t>(WS_WIN_T) + (size_t)512 * D, NCTX, 1024, D}; pg8::StaticOrder S; S.init(NCTX, 1024, c.G, c.bid);
          pg8::EpiBf16 E{c.ws<bf16_t>(WS_KVC), 1024, 1 << 30, nullptr}; pg8::gemm_phase<decltype(E), pg8::StaticOrder, true, true>(c.lds, g, S, E, c.tid); }
    }
    if constexpr (P == 3) { phase_attn(c); phase_gating(c); }
    if constexpr (P == 4) { pg8::Gemm g{c.ws<bf16_t>(WS_MIX), c.ws<bf16_t>(WS_WOUT_T), NTOK, D, D}; pg8::StaticOrder S; S.init(NTOK, D, c.G, c.bid);
        pg8::EpiBf16 E{c.ws<bf16_t>(WS_BIG), D, 1 << 30, nullptr}; pg8::gemm_phase<decltype(E), pg8::StaticOrder, true, true>(c.lds, g, S, E, c.tid); }
    if constexpr (P == 5) phase_ln1(c, 0);
    if constexpr (P == 6) { pg8::Gemm g{c.ws<bf16_t>(WS_HB), c.ws<bf16_t>(WS_WK_T), NTOK, PQN, D}; pg8::StaticOrder S; S.init(NTOK, PQN, c.G, c.bid);
        pg8::EpiF16 E{c.ws<_Float16>(WS_BIG), PQN}; pg8::gemm_phase<decltype(E), pg8::StaticOrder, true, true>(c.lds, g, S, E, c.tid); }
    if constexpr (P == 7) phase_topk(c);
    if constexpr (P == 8) phase_gather_u(c, 0);
    if constexpr (P == 9) phase_gather_v(c, 0);
    if constexpr (P == 10) {
        pg8::Gemm g{c.ws<bf16_t>(WS_HYIN_T), c.ws<bf16_t>(WS_MIX), HY3, NTOK, D}; pg8::StaticOrder S; S.init(HY3, NTOK, c.G, c.bid);
        pg8::EpiBf16 E{c.ws<bf16_t>(WS_BIG), NTOK, 1 << 30, c.in(I_HYBIN)}; pg8::gemm_phase<decltype(E), pg8::StaticOrder, true, true>(c.lds, g, S, E, c.tid); }
    if constexpr (P == 11) phase_hyena_conv(c);
    if constexpr (P == 12) phase_transpose_y(c);
    if constexpr (P == 13) { pg8::Gemm g{c.ws<bf16_t>(WS_HB), c.ws<bf16_t>(WS_HYOUT_T), NTOK, D, D}; pg8::StaticOrder S; S.init(NTOK, D, c.G, c.bid);
        pg8::EpiBf16 E{c.ws<bf16_t>(WS_BIG), D, 1 << 30, nullptr}; pg8::gemm_phase<decltype(E), pg8::StaticOrder, true, true>(c.lds, g, S, E, c.tid); }
    if constexpr (P == 14) phase_ln1(c, 1);
    if constexpr (P == 15) { pg8::Gemm g{c.ws<bf16_t>(WS_HB), c.ws<bf16_t>(WS_WK_T) + (size_t)PQN * D, NTOK, PQN, D}; pg8::StaticOrder S; S.init(NTOK, PQN, c.G, c.bid);
        pg8::EpiF16 E{c.ws<_Float16>(WS_BIG), PQN}; pg8::gemm_phase<decltype(E), pg8::StaticOrder, true, true>(c.lds, g, S, E, c.tid); }
    if constexpr (P == 16) phase_topk(c);
    if constexpr (P == 17) phase_gather_u(c, 1);
    if constexpr (P == 18) phase_gather_v(c, 1);
}
__device__ __forceinline__ int phase_tid(int wave0) {
    int t = wave0 * 64 + (int)__builtin_amdgcn_mbcnt_hi(~0u, __builtin_amdgcn_mbcnt_lo(~0u, 0u)); asm volatile("" : "+v"(t)); return t;
}
__device__ __forceinline__ Ctx make_ctx(const Args* a, unsigned char* lds_raw, int wave0) {
    int t = phase_tid(wave0);
    Ctx c; c.a = a; c.lds = (LAS unsigned char*)lds_raw; c.tid = t; c.lane = c.tid & 63; c.wave = __builtin_amdgcn_readfirstlane(c.tid >> 6); c.G = gridDim.x; c.bid = blockIdx.x; return c;
}
template <int P>
__global__ void __launch_bounds__(NT) phase_kernel(Args args) {
    __shared__ __attribute__((aligned(16))) unsigned char lds_raw[LDS_BYTES];
    const Ctx c = make_ctx(&args, lds_raw, __builtin_amdgcn_readfirstlane((int)threadIdx.x >> 6));
    run_phase<P>(c);
}
#if ONE_LAUNCH
__device__ __forceinline__ XcdBarrier make_xb(const Args* a, unsigned char* lds_raw) { XcdBarrier b; b.bar = (unsigned*)(a->ws + WS_BAR); b.x = xb_xcc_id(); b.st = (volatile LAS unsigned*)((LAS unsigned char*)lds_raw + LDS_BYTES - 16); return b; }
template <int P> __device__ __forceinline__ void run_all(const Args* a, unsigned char* lds_raw, int wave0) {
#ifndef DBG_LO
#define DBG_LO 0
#define DBG_HI NPH
#endif
    if constexpr (P < NPH) {
        if constexpr (P >= DBG_LO && P < DBG_HI) { const Ctx c = make_ctx(a, lds_raw, wave0); run_phase<P>(c); }
        if constexpr (((DUP_MASK >> P) & 1) != 0) { xcd_barrier(make_xb(a, lds_raw), phase_tid(wave0)); const Ctx c2 = make_ctx(a, lds_raw, wave0); run_phase<P>(c2); }
        if constexpr (P + 1 < NPH) { if constexpr (P == 0) cg::this_grid().sync(); else xcd_barrier(make_xb(a, lds_raw), phase_tid(wave0)); run_all<P + 1>(a, lds_raw, wave0); }
    }
}
__global__ void __launch_bounds__(NT) mega(Args args) {
    __shared__ __attribute__((aligned(16))) unsigned char lds_raw[LDS_BYTES];
    volatile LAS unsigned* st = (volatile LAS unsigned*)((LAS unsigned char*)lds_raw + LDS_BYTES - 16);
    const int wave0 = __builtin_amdgcn_readfirstlane((int)threadIdx.x >> 6);
    const int tid0 = phase_tid(wave0);
    if (tid0 == 0) { st[0] = 0u; st[1] = 0u; }
    __syncthreads();
    (void)xcd_barrier_post((unsigned*)(args.ws + WS_BAR), st, tid0);
    run_all<0>(&args, lds_raw, wave0);
}
#endif
template <int P> static void launch_phases(const Args& a, int grid, hipStream_t stream) {
    if constexpr (P < NPH) { hipLaunchKernelGGL(phase_kernel<P>, dim3(grid), dim3(NT), 0, stream, a); launch_phases<P + 1>(a, grid, stream); }
}

extern "C" void kernel_launch(void* const* d_in, const int* in_sizes, int n_in, void* d_out, int out_size, void* d_ws, size_t ws_size, hipStream_t stream) {
    static int grid = 0;
    if (grid == 0) {
        if (n_in != 30 || out_size != NTOK * D || ws_size < WS_END) { fprintf(stderr, "kernel_launch: unexpected shapes (n_in %d out %d ws %zu)\n", n_in, out_size, ws_size); grid = -1; return; }
        int dev = 0, cus = 0, per_cu = 0;
        (void)hipGetDevice(&dev); (void)hipDeviceGetAttribute(&cus, hipDeviceAttributeMultiprocessorCount, dev);
#if ONE_LAUNCH
        (void)hipOccupancyMaxActiveBlocksPerMultiprocessor(&per_cu, (const void*)mega, NT, 0);
#else
        (void)hipOccupancyMaxActiveBlocksPerMultiprocessor(&per_cu, (const void*)phase_kernel<2>, NT, 0);
#endif
        if (per_cu < 1) { fprintf(stderr, "kernel_launch: occupancy query says %d blocks per CU\n", per_cu); grid = -1; return; }
        grid = cus < 256 ? cus : 256;
        grid &= ~7;
    }
    if (grid < 0) return;
    Args a{};
    for (int i = 0; i < 30; ++i) a.in[i] = (const float*)d_in[i];
    a.out = (float*)d_out; a.ws = (unsigned char*)d_ws;
#if ONE_LAUNCH
    {
        a.ph_lo = 0; a.ph_hi = NPH;
        (void)hipMemsetAsync((char*)d_ws + WS_BAR, 0, XCD_BAR_WORDS * sizeof(unsigned), stream);
        void* kargs[] = {&a};
        hipError_t e = hipLaunchCooperativeKernel((const void*)mega, dim3(grid), dim3(NT), kargs, 0, stream);
        if (e != hipSuccess) fprintf(stderr, "cooperative launch failed: %s (grid %d)\n", hipGetErrorString(e), grid);
    }
#else
    a.ph_lo = 0; a.ph_hi = NPH; launch_phases<0>(a, grid, stream);
#endif
}
```

```cpp
#include <hip/hip_runtime.h>
#include <hip/hip_cooperative_groups.h>
#include <cstdio>
#include <cstdint>
namespace cg = cooperative_groups;

#ifndef FFT_PROBE
#define FFT_PROBE 0
#endif
#ifndef DRY_GATHER
#define DRY_GATHER 0
#endif
#ifndef DUP_MASK
#define DUP_MASK 0
#endif
#ifndef ONE_LAUNCH
#define ONE_LAUNCH 1
#endif

#define LAS __attribute__((address_space(3)))
typedef unsigned short bf16_t;
typedef short bf16x8 __attribute__((ext_vector_type(8)));
typedef short s16x4 __attribute__((ext_vector_type(4)));
typedef float f32x4 __attribute__((ext_vector_type(4)));
typedef float f32x16 __attribute__((ext_vector_type(16)));
typedef float f32x2 __attribute__((ext_vector_type(2)));
typedef unsigned u32x4 __attribute__((ext_vector_type(4)));
typedef unsigned u32x2 __attribute__((ext_vector_type(2)));
typedef short v4i16_t __attribute__((ext_vector_type(4)));

constexpr int D = 1024, NBATCH = 2, SEQ = 16384, NTOK = NBATCH * SEQ;
constexpr int CTXL = 256, NCTX = NBATCH * CTXL;
constexpr int ABIN = 2560, HY3 = 3072, PQN = 2048;
constexpr int NT = 512;
constexpr int LDS_BYTES = 160 * 1024;
constexpr float DN_ALPHA = 1.41421356237309515f;
constexpr float LN_EPS = 1e-5f;

constexpr size_t MiB = 1024 * 1024;
constexpr size_t WS_WIN_T   = 0;
constexpr size_t WS_WOUT_T  = 5 * MiB;
constexpr size_t WS_HYIN_T  = 7 * MiB;
constexpr size_t WS_HYOUT_T = 13 * MiB;
constexpr size_t WS_WK_T    = 15 * MiB;
constexpr size_t WS_WS_BF   = 23 * MiB;
constexpr size_t WS_MOD     = 23 * MiB + 256 * 1024;
constexpr size_t WS_MODC    = WS_MOD + 128 * 1024;
constexpr size_t WS_TWODD   = WS_MODC + 32 * 1024;
constexpr size_t WS_TWS     = WS_TWODD + 128 * 1024;
constexpr size_t WS_BAR     = 23 * MiB + 832 * 1024;
constexpr size_t WS_HID2    = 24 * MiB;
constexpr size_t WS_W3T     = 26 * MiB;
constexpr size_t WS_KVC     = 28 * MiB;
constexpr size_t WS_HCTX    = 29 * MiB;
constexpr size_t WS_HB      = 32 * MiB;
constexpr size_t WS_MIX     = 96 * MiB;
constexpr size_t WS_BIG     = 160 * MiB;
constexpr size_t WS_DQ      = 23 * MiB + 576 * 1024;
constexpr size_t WS_FILT    = 352 * MiB;
constexpr size_t WS_TAB8    = 416 * MiB;
constexpr size_t WS_IDX     = 480 * MiB;
constexpr size_t WS_GATE    = 488 * MiB;
constexpr size_t WS_END     = 512 * MiB;

struct Args {
    const float* in[30];
    float* out;
    unsigned char* ws;
    int ph_lo, ph_hi;
};
enum { I_X = 0, I_C, I_CTX, I_CCTX, I_MODW, I_MODB, I_LNG, I_LNB, I_ABWIN, I_ABWOUT, I_RPB, I_GMWS, I_GMBS, I_HYWIN, I_HYBIN, I_HYCW, I_HYCB,
       I_W1, I_B1, I_F1, I_W2, I_B2, I_F2, I_W3, I_HYD, I_HYWOUT, I_PWQ, I_PKEYS, I_PU, I_PV };

__device__ __forceinline__ unsigned f2bf(float f) { unsigned u = __builtin_bit_cast(unsigned, f); return (u + 0x7fffu + ((u >> 16) & 1u)) >> 16; }
__device__ __forceinline__ float bf2f(unsigned b) { return __builtin_bit_cast(float, (b & 0xffffu) << 16); }
__device__ __forceinline__ unsigned pk2(float lo, float hi) { return f2bf(lo) | (f2bf(hi) << 16); }
__device__ __forceinline__ unsigned cvt_pk_bf16(float lo, float hi) { unsigned r; asm volatile("v_cvt_pk_bf16_f32 %0, %1, %2" : "=v"(r) : "v"(lo), "v"(hi)); return r; }
template <int M> __device__ __forceinline__ float sx(float v) {
    return __builtin_bit_cast(float, __builtin_amdgcn_ds_swizzle(__builtin_bit_cast(int, v), (M << 10) | 0x1f));
}
template <int CTRL> __device__ __forceinline__ float dppx(float v) {
    return __builtin_bit_cast(float, __builtin_amdgcn_update_dpp(0, __builtin_bit_cast(int, v), CTRL, 0xf, 0xf, false));
}
__device__ __forceinline__ float lane_get(float v, int srclane) { return __builtin_bit_cast(float, __builtin_amdgcn_ds_bpermute(srclane << 2, __builtin_bit_cast(int, v))); }
__device__ __forceinline__ int lane_geti(int v, int srclane) { return __builtin_amdgcn_ds_bpermute(srclane << 2, v); }
__device__ __forceinline__ float sx32(float v, int lane) { return lane_get(v, lane ^ 32); }
__device__ __forceinline__ float wave_sum(float v, int lane) { v += dppx<0xB1>(v); v += dppx<0x4E>(v); v += dppx<0x141>(v); v += dppx<0x140>(v); v += sx<16>(v); v += sx32(v, lane); return v; }
__device__ __forceinline__ float wave_max(float v, int lane) { v = fmaxf(v, dppx<0xB1>(v)); v = fmaxf(v, dppx<0x4E>(v)); v = fmaxf(v, dppx<0x141>(v)); v = fmaxf(v, dppx<0x140>(v)); v = fmaxf(v, sx<16>(v)); v = fmaxf(v, sx32(v, lane)); return v; }
__device__ __forceinline__ float gelu_erf(float v) { return 0.5f * v * (1.0f + erff(v * 0.70710678118654752f)); }

namespace pg8 {
constexpr int BM = 256, BK = 64, HALF = 128, HTB = HALF * BK * 2, STAGE_BYTES = 8 * HTB, NXCD = 8, WGM = 8;
__host__ __device__ __forceinline__ int lds_byte(int r, int c) { const int st = (r >> 4) * 2 + (c >> 5), rr = r & 15, cc = c & 31, ob = rr * 64 + cc * 2; return st * 1024 + (ob ^ (((ob >> 9) & 1) << 5)); }
__host__ __device__ __forceinline__ void stage_rc(int b, int& R, int& C) { const int st = b / 1024, sb = b % 1024, swz = sb ^ (((sb >> 9) & 1) << 5); R = (st >> 1) * 16 + swz / 64; C = (st & 1) * 32 + (swz % 64) / 2; }
__host__ __device__ __forceinline__ int perm32(int rho) { const int n = rho >> 4, i = rho & 15; return 8 * (i >> 2) + 4 * n + (i & 3); }
struct Unit { int pm, pn; };
struct Gemm { const bf16_t* A; const bf16_t* Bt; int M, N, K; };
struct StaticOrder {
    int nM, nN, nwg, G, c, wgm;
    __host__ __device__ void init(int M, int N, int G_, int c_, int wgm_ = WGM) { nM = M / BM; nN = N / BM; nwg = nM * nN; G = G_; c = c_; wgm = wgm_; }
    __host__ __device__ bool next(int i, Unit& u) const {
        const long L = (long)i * G + c; if (L >= nwg) return false;
        int wgid = (int)L; { const int q = nwg / NXCD, r = nwg % NXCD, xcd = wgid % NXCD, off = wgid / NXCD; wgid = (xcd < r ? xcd * (q + 1) : r * (q + 1) + (xcd - r) * q) + off; }
        const int nig = wgm * nN, gid = wgid / nig, fm = gid * wgm, gsz = (nM - fm) < wgm ? (nM - fm) : wgm;
        u.pm = fm + ((wgid % nig) % gsz); u.pn = (wgid % nig) / gsz; return true;
    }
};

__device__ __forceinline__ f32x2 gelu_pk(f32x2 v) {
    const f32x2 av = __builtin_elementwise_abs(v), d = av * 0.2316418882f + 1.0f;
    f32x2 t; t.x = __builtin_amdgcn_rcpf(d.x); t.y = __builtin_amdgcn_rcpf(d.y);
    f32x2 q = t * 0.5307027145f + (-0.7265760135f); q = q * t + 0.7107068705f; q = q * t + (-0.142248368f); q = q * t + 0.127414796f; q = q * t;
    const f32x2 s = (v * v) * (-0.72134752044f);
    f32x2 e; e.x = __builtin_amdgcn_exp2f(s.x); e.y = __builtin_amdgcn_exp2f(s.y);
    const f32x2 m = v * (q * e), r = v - m;
    f32x2 o; o.x = v.x < 0.f ? m.x : r.x; o.y = v.y < 0.f ? m.y : r.y; return o;
}

struct EpiBf16 {
    static constexpr bool PERM = true;
    bf16_t* O; int ldc; int gelu_from_pn; const float* rowbias;
    __device__ __forceinline__ void operator()(const f32x4 (&acc)[2][2][4][2], const Unit& u, int wr, int wc, int fr, int fq) const {
        const int row0 = u.pm * BM + wr * 64 + fr;
        const int col0 = u.pn * BM + wc * 32 + 8 * fq;
        const bool act = u.pn >= gelu_from_pn;
#pragma unroll
        for (int ai = 0; ai < 2; ++ai)
#pragma unroll
            for (int m = 0; m < 4; ++m) {
                const int row = row0 + ai * HALF + m * 16;
                const float rb = rowbias ? rowbias[row] : 0.f;
                bf16_t* rowp = O + (size_t)row * ldc + col0;
#pragma unroll
                for (int bj = 0; bj < 2; ++bj) {
                    f32x4 v0 = acc[ai][bj][m][0] + rb, v1 = acc[ai][bj][m][1] + rb;
                    if (act) { f32x2 a = gelu_pk((f32x2){v0[0], v0[1]}), b = gelu_pk((f32x2){v0[2], v0[3]}), c = gelu_pk((f32x2){v1[0], v1[1]}), d = gelu_pk((f32x2){v1[2], v1[3]});
                        v0 = (f32x4){a.x, a.y, b.x, b.y}; v1 = (f32x4){c.x, c.y, d.x, d.y}; }
                    u32x4 w; w.x = cvt_pk_bf16(v0[0], v0[1]); w.y = cvt_pk_bf16(v0[2], v0[3]); w.z = cvt_pk_bf16(v1[0], v1[1]); w.w = cvt_pk_bf16(v1[2], v1[3]);
                    *(u32x4*)(rowp + bj * HALF) = w;
                }
            }
    }
};
struct EpiF16 {
    static constexpr bool PERM = true;
    _Float16* O; int ldc;
    __device__ __forceinline__ void operator()(const f32x4 (&acc)[2][2][4][2], const Unit& u, int wr, int wc, int fr, int fq) const {
        typedef _Float16 h8 __attribute__((ext_vector_type(8)));
        const int row0 = u.pm * BM + wr * 64 + fr;
        const int col0 = u.pn * BM + wc * 32 + 8 * fq;
#pragma unroll
        for (int ai = 0; ai < 2; ++ai)
#pragma unroll
            for (int m = 0; m < 4; ++m) {
                _Float16* rowp = O + (size_t)(row0 + ai * HALF + m * 16) * ldc + col0;
#pragma unroll
                for (int bj = 0; bj < 2; ++bj) {
                    const f32x4 v0 = acc[ai][bj][m][0], v1 = acc[ai][bj][m][1];
                    h8 w; w[0] = (_Float16)v0[0]; w[1] = (_Float16)v0[1]; w[2] = (_Float16)v0[2]; w[3] = (_Float16)v0[3];
                    w[4] = (_Float16)v1[0]; w[5] = (_Float16)v1[1]; w[6] = (_Float16)v1[2]; w[7] = (_Float16)v1[3];
                    *(h8*)(rowp + bj * HALF) = w;
                }
            }
    }
};
struct EpiRes {
    static constexpr bool PERM = false;
    const float* res; float* out; const float* gate;
    __device__ __forceinline__ void operator()(const f32x4 (&acc)[2][2][4][2], const Unit& u, int wr, int wc, int fr, int fq) const {
        const int rowt = u.pm * BM;
        const float* g = gate + (size_t)(rowt / SEQ) * 6144;
        const int col0 = u.pn * BM + wc * 32 + 4 * fq;
#pragma unroll
        for (int bj = 0; bj < 2; ++bj)
#pragma unroll
            for (int n = 0; n < 2; ++n) {
                const int col = col0 + bj * HALF + n * 16;
                const f32x4 gv = *(const f32x4*)(g + col);
#pragma unroll
                for (int ai = 0; ai < 2; ++ai)
#pragma unroll
                    for (int m = 0; m < 4; ++m) {
                        const size_t off = (size_t)(rowt + ai * HALF + wr * 64 + m * 16 + fr) * D + col;
                        const f32x4 rv = *(const f32x4*)(res + off);
                        *(f32x4*)(out + off) = rv * DN_ALPHA + gv * acc[ai][bj][m][n];
                    }
            }
    }
};

template <class Epi, class Sched, bool ALIGN_EPI = false, bool SP2 = false>
__device__ __forceinline__ void gemm_phase(LAS unsigned char* lds, const Gemm g, const Sched& S, const Epi& E, const int tid) {
    const int wid = __builtin_amdgcn_readfirstlane(tid >> 6), lane = tid & 63, wr = wid >> 2, wc = wid & 3, fr = lane & 15, fq = lane >> 4;
    const int K = g.K, nt = K / BK;
    unsigned voffA[2], voffB[2];
#pragma unroll
    for (int i = 0; i < 2; ++i) { int R, C; stage_rc(tid * 16 + i * 8192, R, C); const int Rb = Epi::PERM ? ((R & ~31) + perm32(R & 31)) : R;
        voffA[i] = (unsigned)(R * K + C) * 2u; voffB[i] = (unsigned)(Rb * K + C) * 2u; }
    const size_t kstep = (size_t)(BK * 2);
    const size_t hstep = (size_t)HALF * K * 2;
    const size_t tstep = 2 * hstep;
    const unsigned ldsw = (unsigned)wid * 1024u;
    const int aoff = lds_byte(wr * 64 + fr, fq * 8), boff = lds_byte(wc * 32 + fr, fq * 8);
#define PG8_SA(b, h) (((b) * 2 + (h)) * HTB)
#define PG8_SB(b, h) ((4 + (b) * 2 + (h)) * HTB)
#define PG8_STAGE(bufoff, gbase, voff) do { _Pragma("unroll") for (int _i = 0; _i < 2; ++_i) \
        __builtin_amdgcn_global_load_lds((const unsigned*)((const char*)(gbase) + (voff)[_i]), (LAS unsigned*)(lds + (bufoff) + ldsw + _i * 8192), 16, 0, 0); } while (0)
#define PG8_LDA(dst, b, h) do { _Pragma("unroll") for (int m = 0; m < 4; ++m) _Pragma("unroll") for (int k = 0; k < 2; ++k) dst[m][k] = *(const LAS bf16x8*)(lds + PG8_SA(b, h) + aoff + m * 2048 + k * 1024); } while (0)
#define PG8_LDB(dst, b, h) do { _Pragma("unroll") for (int n = 0; n < 2; ++n) _Pragma("unroll") for (int k = 0; k < 2; ++k) dst[n][k] = *(const LAS bf16x8*)(lds + PG8_SB(b, h) + boff + n * 2048 + k * 1024); } while (0)
#define PG8_MMA(ai, bj, At, Bt) do { __builtin_amdgcn_s_setprio(1); _Pragma("unroll") for (int m = 0; m < 4; ++m) _Pragma("unroll") for (int n = 0; n < 2; ++n) _Pragma("unroll") for (int k = 0; k < 2; ++k) \
        acc[ai][bj][m][n] = __builtin_amdgcn_mfma_f32_16x16x32_bf16(Bt[n][k], At[m][k], acc[ai][bj][m][n], 0, 0, 0); __builtin_amdgcn_s_setprio(0); } while (0)
#define PG8_WAIT_V(n) asm volatile("s_waitcnt vmcnt(" #n ")" ::: "memory")
#define PG8_WAIT_L(n) asm volatile("s_waitcnt lgkmcnt(" #n ")" ::: "memory")
#define PG8_BAR __builtin_amdgcn_s_barrier()
#define PG8_SCHED __builtin_amdgcn_sched_barrier(0)
    Unit cur, nxt; int ui = 0;
    if (!S.next(0, cur)) return;
    f32x4 acc[2][2][4][2];
#pragma unroll
    for (int a = 0; a < 2; ++a)
#pragma unroll
        for (int b = 0; b < 2; ++b)
#pragma unroll
            for (int m = 0; m < 4; ++m)
#pragma unroll
                for (int n = 0; n < 2; ++n) acc[a][b][m][n] = (f32x4){0.f, 0.f, 0.f, 0.f};
    bf16x8 At[4][2], B0[2][2], B1[2][2];
    const char* cA = (const char*)g.A + (size_t)cur.pm * tstep; const char* cB = (const char*)g.Bt + (size_t)cur.pn * tstep;
    if constexpr (SP2) {
        PG8_STAGE(PG8_SB(0, 0), cB, voffB); PG8_STAGE(PG8_SB(0, 1), cB + hstep, voffB); PG8_STAGE(PG8_SA(0, 0), cA, voffA); PG8_STAGE(PG8_SA(0, 1), cA + hstep, voffA);
        if (wr == 1) PG8_BAR;
        PG8_WAIT_V(2); PG8_BAR;
        PG8_STAGE(PG8_SB(1, 0), cB + kstep, voffB); PG8_STAGE(PG8_SA(1, 0), cA + kstep, voffA); PG8_STAGE(PG8_SB(1, 1), cB + hstep + kstep, voffB);
        PG8_WAIT_V(6); PG8_BAR;
    } else {
        PG8_STAGE(PG8_SB(0, 0), cB, voffB); PG8_STAGE(PG8_SA(0, 0), cA, voffA); PG8_STAGE(PG8_SB(0, 1), cB + hstep, voffB); PG8_STAGE(PG8_SA(0, 1), cA + hstep, voffA);
        if (wr == 1) PG8_BAR;
        PG8_WAIT_V(4); PG8_BAR;
        PG8_STAGE(PG8_SB(1, 0), cB + kstep, voffB); PG8_STAGE(PG8_SA(1, 0), cA + kstep, voffA); PG8_STAGE(PG8_SB(1, 1), cB + hstep + kstep, voffB);
        PG8_WAIT_V(6); PG8_BAR;
    }
    for (;;) {
        const bool has_next = S.next(ui + 1, nxt);
        const char* nA = has_next ? (const char*)g.A + (size_t)nxt.pm * tstep : cA; const char* nB = has_next ? (const char*)g.Bt + (size_t)nxt.pn * tstep : cB;
        for (int t = 0; t < nt; t += 2) {
            const bool last = (t == nt - 2);
            const char* a1 = cA + (size_t)(t + 1) * kstep;
            const char* a2 = last ? nA : cA + (size_t)(t + 2) * kstep; const char* b2 = last ? nB : cB + (size_t)(t + 2) * kstep;
            const char* a3 = a2 + kstep; const char* b3 = b2 + kstep;
            if constexpr (SP2) {
            PG8_LDB(B0, 0, 0); PG8_LDB(B1, 0, 1); PG8_SCHED; PG8_LDA(At, 0, 0); PG8_STAGE(PG8_SA(1, 1), a1 + hstep, voffA);
            PG8_WAIT_V(8); PG8_WAIT_L(0); PG8_BAR; PG8_MMA(0, 0, At, B0); PG8_MMA(0, 1, At, B1); PG8_BAR; PG8_SCHED;
            PG8_LDA(At, 0, 1); PG8_STAGE(PG8_SB(0, 0), b2, voffB); PG8_STAGE(PG8_SB(0, 1), b2 + hstep, voffB); PG8_STAGE(PG8_SA(0, 0), a2, voffA);
            PG8_WAIT_V(8); PG8_WAIT_L(0); PG8_BAR; PG8_MMA(1, 0, At, B0); PG8_MMA(1, 1, At, B1); PG8_BAR; PG8_SCHED;
            PG8_LDB(B0, 1, 0); PG8_LDB(B1, 1, 1); PG8_SCHED; PG8_LDA(At, 1, 0); PG8_STAGE(PG8_SA(0, 1), a2 + hstep, voffA);
            PG8_WAIT_V(8); PG8_WAIT_L(0); PG8_BAR; PG8_MMA(0, 0, At, B0); PG8_MMA(0, 1, At, B1); PG8_BAR; PG8_SCHED;
            PG8_LDA(At, 1, 1); PG8_STAGE(PG8_SB(1, 0), b3, voffB); PG8_STAGE(PG8_SB(1, 1), b3 + hstep, voffB); PG8_STAGE(PG8_SA(1, 0), a3, voffA);
            PG8_WAIT_V(8); PG8_WAIT_L(0); PG8_BAR; PG8_MMA(1, 0, At, B0); PG8_MMA(1, 1, At, B1); PG8_BAR; PG8_SCHED;
            } else {
            PG8_LDB(B0, 0, 0); PG8_SCHED; PG8_LDA(At, 0, 0); PG8_STAGE(PG8_SA(1, 1), a1 + hstep, voffA);
            PG8_WAIT_L(8); PG8_BAR; PG8_WAIT_L(0); PG8_MMA(0, 0, At, B0); PG8_BAR; PG8_SCHED;
            PG8_LDB(B1, 0, 1); PG8_STAGE(PG8_SB(0, 0), b2, voffB);
            PG8_BAR; PG8_WAIT_L(0); PG8_MMA(0, 1, At, B1); PG8_BAR;
            PG8_LDA(At, 0, 1); PG8_STAGE(PG8_SA(0, 0), a2, voffA);
            PG8_BAR; PG8_WAIT_L(0); PG8_MMA(1, 0, At, B0); PG8_BAR; PG8_SCHED;
            PG8_STAGE(PG8_SB(0, 1), b2 + hstep, voffB);
            PG8_WAIT_V(6); PG8_BAR; PG8_MMA(1, 1, At, B1); PG8_BAR;
            PG8_LDB(B0, 1, 0); PG8_SCHED; PG8_LDA(At, 1, 0); PG8_STAGE(PG8_SA(0, 1), a2 + hstep, voffA);
            PG8_WAIT_L(8); PG8_BAR; PG8_WAIT_L(0); PG8_MMA(0, 0, At, B0); PG8_BAR; PG8_SCHED;
            PG8_LDB(B1, 1, 1); PG8_STAGE(PG8_SB(1, 0), b3, voffB);
            PG8_BAR; PG8_WAIT_L(0); PG8_MMA(0, 1, At, B1); PG8_BAR;
            PG8_LDA(At, 1, 1); PG8_STAGE(PG8_SA(1, 0), a3, voffA);
            PG8_BAR; PG8_WAIT_L(0); PG8_MMA(1, 0, At, B0); PG8_BAR; PG8_SCHED;
            PG8_STAGE(PG8_SB(1, 1), b3 + hstep, voffB);
            PG8_WAIT_V(6); PG8_BAR; PG8_MMA(1, 1, At, B1); PG8_BAR;
            }
        }
        if constexpr (ALIGN_EPI) { if (wr == 0) PG8_BAR; }
        E(acc, cur, wr, wc, fr, fq);
        if (!has_next) break;
#pragma unroll
        for (int a = 0; a < 2; ++a)
#pragma unroll
            for (int b = 0; b < 2; ++b)
#pragma unroll
                for (int m = 0; m < 4; ++m)
#pragma unroll
                    for (int n = 0; n < 2; ++n) acc[a][b][m][n] = (f32x4){0.f, 0.f, 0.f, 0.f};
        cur = nxt; cA = nA; cB = nB; ++ui;
        if constexpr (ALIGN_EPI) { if (wr == 1) PG8_BAR; }
    }
    PG8_WAIT_V(0);
    if constexpr (!ALIGN_EPI) { if (wr == 0) PG8_BAR; }
    PG8_BAR;
#undef PG8_SA
#undef PG8_SB
#undef PG8_STAGE
#undef PG8_LDA
#undef PG8_LDB
#undef PG8_MMA
#undef PG8_WAIT_V
#undef PG8_WAIT_L
#undef PG8_BAR
#undef PG8_SCHED
}
}

struct Ctx {
    const Args* a; LAS unsigned char* lds; int tid, lane, wave, G, bid;
    template <class T> __device__ __forceinline__ T* ws(size_t off) const { return (T*)(a->ws + off); }
    __device__ __forceinline__ const float* in(int i) const { return a->in[i]; }
};

__device__ void transpose_cvt(const Ctx& c, const float* in, bf16_t* out, int K, int N) {
    LAS float* t = (LAS float*)c.lds;
    const int tk = K / 64, tn = N / 64, nt = tk * tn;
    for (int tile0 = c.bid * 4; tile0 < nt; tile0 += c.G * 4) {
        __syncthreads();
        float v[4][8];
#pragma unroll
        for (int u = 0; u < 4; ++u) { const int tile = tile0 + u < nt ? tile0 + u : tile0, k0 = (tile / tn) * 64, n0 = (tile % tn) * 64;
#pragma unroll
            for (int i = 0; i < 8; ++i) { const int e = c.tid + i * NT, r = e >> 6, cc = e & 63; v[u][i] = in[(size_t)(k0 + r) * N + n0 + cc]; } }
#pragma unroll
        for (int u = 0; u < 4; ++u)
#pragma unroll
            for (int i = 0; i < 8; ++i) { const int e = c.tid + i * NT, r = e >> 6, cc = e & 63; t[u * 64 * 65 + r * 65 + cc] = v[u][i]; }
        __syncthreads();
#pragma unroll
        for (int u = 0; u < 4; ++u) if (tile0 + u < nt) { const int tile = tile0 + u, k0 = (tile / tn) * 64, n0 = (tile % tn) * 64;
#pragma unroll
            for (int i = 0; i < 8; ++i) { const int e = c.tid + i * NT, r = e >> 6, cc = e & 63; out[(size_t)(n0 + r) * K + k0 + cc] = (bf16_t)f2bf(t[u * 64 * 65 + cc * 65 + r]); } }
    }
    __syncthreads();
}

__device__ void phase_prep(const Ctx& c) {
    transpose_cvt(c, c.in(I_ABWIN), c.ws<bf16_t>(WS_WIN_T), D, ABIN);
    transpose_cvt(c, c.in(I_ABWOUT), c.ws<bf16_t>(WS_WOUT_T), D, D);
    transpose_cvt(c, c.in(I_HYWIN), c.ws<bf16_t>(WS_HYIN_T), D, HY3);
    transpose_cvt(c, c.in(I_HYWOUT), c.ws<bf16_t>(WS_HYOUT_T), D, D);
    {
        LAS float* sv = (LAS float*)c.lds;
        LAS float* red = sv + 3 * 1024;
        __syncthreads();
        for (int e = c.tid; e < 3 * 1024; e += NT) { const int w = e >> 10, k = e & 1023; const float v = w < 2 ? c.in(I_C)[w * D + k] : c.in(I_CCTX)[k]; sv[e] = v / (1.0f + __expf(-v)); }
        __syncthreads();
        const int jj = c.tid & 63, kg = c.tid >> 6;
        for (int item = c.bid; item < 2 * 96; item += c.G) {
            const int layer = item / 96, j = (item % 96) * 64 + jj;
            const float* w = c.in(I_MODW) + (size_t)layer * D * 6144 + j;
            float a0 = 0.f, a1 = 0.f, a2 = 0.f;
#pragma unroll 8
            for (int kk = 0; kk < 128; ++kk) { const int k = kg * 128 + kk; const float wv = w[(size_t)k * 6144]; a0 += sv[k] * wv; a1 += sv[1024 + k] * wv; a2 += sv[2048 + k] * wv; }
            red[(0 * 8 + kg) * 64 + jj] = a0; red[(1 * 8 + kg) * 64 + jj] = a1; red[(2 * 8 + kg) * 64 + jj] = a2;
            __syncthreads();
            if (c.tid < 192) { const int w3 = c.tid >> 6; float s = 0.f;
#pragma unroll
                for (int q = 0; q < 8; ++q) s += red[(w3 * 8 + q) * 64 + jj];
                s += c.in(I_MODB)[layer * 6144 + j];
                if (w3 < 2) c.ws<float>(WS_MOD)[(layer * 2 + w3) * 6144 + j] = s; else if (layer == 0) c.ws<float>(WS_MODC)[j] = s; }
            __syncthreads();
        }
    }
    {
        LAS float* z = (LAS float*)c.lds;
        LAS float* h1 = z + 8 * 40;
        const int tt = c.tid >> 6, j = c.tid & 63;
        for (int item = c.bid; item < SEQ / 8; item += c.G) {
            __syncthreads();
            if (c.tid < 8 * 33) { const int t8 = c.tid / 33, e = c.tid % 33, t = item * 8 + t8; float v;
                if (e == 0) v = (float)((double)t / (double)(SEQ - 1));
                else { const int k = (e - 1) & 15; const double band = 1e-4 + (double)k * ((15.0 - 1e-4) / 15.0); const double rev = 2.0 * band * (double)t / (double)SEQ;
                    v = (e <= 16) ? (float)cospi(rev) : (float)(-sinpi(rev)); }
                z[t8 * 40 + e] = v; }
            __syncthreads();
            { float s = c.in(I_B1)[j];
#pragma unroll
              for (int e = 0; e < 33; ++e) s += z[tt * 40 + e] * c.in(I_W1)[e * 64 + j];
              h1[tt * 64 + j] = sinf(c.in(I_F1)[j] * s); }
            __syncthreads();
            { float s = c.in(I_B2)[j];
#pragma unroll 8
              for (int m = 0; m < 64; ++m) s += h1[tt * 64 + m] * c.in(I_W2)[m * 64 + j];
              c.ws<bf16_t>(WS_HID2)[(size_t)(item * 8 + tt) * 64 + j] = (bf16_t)f2bf(sinf(c.in(I_F2)[j] * s)); }
        }
        __syncthreads();
    }
    {
        LAS bf16_t* kyb = (LAS bf16_t*)c.lds;
        LAS bf16_t* wqb = kyb + 128 * 136;
        const int l31 = c.lane & 31, hh = c.lane >> 5;
        for (int item = c.bid; item < 2 * 16 * 8; item += c.G) {
            const int layer = item / 128, hp = (item / 8) % 16, kt = item % 8;
            __syncthreads();
#pragma unroll
            for (int i = 0; i < 8; ++i) { const int idx = c.tid + i * NT, r = idx >> 5, q4 = (idx & 31) * 4;
                const f32x4 kv = *(const f32x4*)(c.in(I_PKEYS) + (((size_t)layer * 16 + hp) * 128 + r) * 128 + q4);
                const f32x4 wv = *(const f32x4*)(c.in(I_PWQ) + ((size_t)layer * D + kt * 128 + r) * PQN + hp * 128 + q4);
                *(LAS u32x2*)(kyb + r * 136 + q4) = (u32x2){pk2(kv[0], kv[1]), pk2(kv[2], kv[3])};
                *(LAS u32x2*)(wqb + r * 136 + q4) = (u32x2){pk2(wv[0], wv[1]), pk2(wv[2], wv[3])}; }
            __syncthreads();
            const int mt = c.wave & 3, ntb = (c.wave >> 2) * 2;
            f32x16 acc[2];
#pragma unroll
            for (int j = 0; j < 2; ++j)
#pragma unroll
                for (int i = 0; i < 16; ++i) acc[j][i] = 0.f;
#pragma unroll
            for (int ks = 0; ks < 8; ++ks) {
                const bf16x8 af = *(const LAS bf16x8*)(kyb + (mt * 32 + l31) * 136 + ks * 16 + hh * 8);
#pragma unroll
                for (int j = 0; j < 2; ++j) { const bf16x8 bfr = *(const LAS bf16x8*)(wqb + ((ntb + j) * 32 + l31) * 136 + ks * 16 + hh * 8);
                    acc[j] = __builtin_amdgcn_mfma_f32_32x32x16_bf16(af, bfr, acc[j], 0, 0, 0); }
            }
            bf16_t* o = c.ws<bf16_t>(WS_WK_T) + ((size_t)layer * PQN + hp * 128) * D + kt * 128;
#pragma unroll
            for (int j = 0; j < 2; ++j)
#pragma unroll
                for (int i = 0; i < 16; ++i) { const int key = mt * 32 + (i & 3) + 8 * (i >> 2) + 4 * hh;
                    o[(size_t)key * D + (ntb + j) * 32 + l31] = (bf16_t)f2bf(acc[j][i]); }
        }
        __syncthreads();
    }
    for (int e = c.bid * NT + c.tid; e < 4 * 128 * 128; e += c.G * NT) c.ws<bf16_t>(WS_WS_BF)[e] = (bf16_t)f2bf(c.in(I_GMWS)[e]);
    for (int e = c.bid * NT + c.tid; e < 64 * 2048; e += c.G * NT) { const int j = e >> 11, col = e & 2047; c.ws<bf16_t>(WS_W3T)[col * 64 + j] = (bf16_t)f2bf(c.in(I_W3)[e]); }
    for (int e = c.bid * NT + c.tid; e < 16384 + 1024 + 64 + 4; e += c.G * NT) {
        double rev; f32x2* dst;
        if (e < 16384) { rev = (double)e / 32768.0; dst = c.ws<f32x2>(WS_TWODD) + e; }
        else if (e < 16384 + 1024) { rev = (double)(e - 16384) / 16384.0; dst = c.ws<f32x2>(WS_TWS) + (e - 16384); }
        else if (e < 16384 + 1024 + 64) { rev = (double)(e - 17408) / 1024.0; dst = c.ws<f32x2>(WS_TWS) + (e - 16384); }
        else { rev = (double)(e - 17472) / 64.0; dst = c.ws<f32x2>(WS_TWS) + (e - 16384); }
        double sn, cs; sincospi(-2.0 * rev, &sn, &cs);
        *dst = (f32x2){(float)cs, (float)sn};
    }
    {
        typedef float v16f __attribute__((ext_vector_type(16)));
        typedef unsigned v6u __attribute__((ext_vector_type(6)));
        const int hh = c.lane >> 5, r = c.lane & 31;
        for (int row0 = (c.bid * 8 + c.wave) * 4; row0 < 4 * 16384; row0 += c.G * 8 * 4) {
            f32x4 v[2][8]; float mx[2];
#pragma unroll
            for (int q = 0; q < 2; ++q) { const int row = row0 + 2 * q + hh, which = row >> 14, rr = row & 16383, layer = which >> 1;
                const float* src = ((which & 1) ? c.in(I_PV) : c.in(I_PU)) + ((size_t)layer * 16384 + rr) * D + 4 * r;
#pragma unroll
                for (int m = 0; m < 8; ++m) v[q][m] = __builtin_nontemporal_load((const f32x4*)(src + 128 * m)); }
#pragma unroll
            for (int q = 0; q < 2; ++q) { float x = 0.f;
#pragma unroll
                for (int m = 0; m < 8; ++m) x = fmaxf(x, fmaxf(fmaxf(fabsf(v[q][m][0]), fabsf(v[q][m][1])), fmaxf(fabsf(v[q][m][2]), fabsf(v[q][m][3]))));
                mx[q] = x; }
#pragma unroll
            for (int q = 0; q < 2; ++q) { float x = mx[q]; x = fmaxf(x, sx<16>(x)); x = fmaxf(x, sx<8>(x)); x = fmaxf(x, sx<4>(x)); x = fmaxf(x, sx<2>(x)); x = fmaxf(x, sx<1>(x)); mx[q] = x; }
#pragma unroll
            for (int q = 0; q < 2; ++q) { const int row = row0 + 2 * q + hh; const float m1 = fmaxf(mx[q], 1e-30f), sc = 7.0f / m1;
                v16f a, bb;
#pragma unroll
                for (int i = 0; i < 16; ++i) { a[i] = v[q][i >> 1][2 * (i & 1)] * sc; bb[i] = v[q][i >> 1][2 * (i & 1) + 1] * sc; }
                const v6u p = __builtin_amdgcn_cvt_scalef32_2xpk16_fp6_f32(a, bb, 1.0f);
                unsigned char* dst = c.ws<unsigned char>(WS_TAB8) + (size_t)row * 768 + 24 * r;
                *(u32x2*)dst = (u32x2){p[0], p[1]}; *(u32x2*)(dst + 8) = (u32x2){p[2], p[3]}; *(u32x2*)(dst + 16) = (u32x2){p[4], p[5]};
                if (r == 0) c.ws<float>(WS_DQ)[(((row >> 15) * 16384) + (row & 16383)) * 2 + ((row >> 14) & 1)] = m1 * (1.0f / 7.0f); }
        }
    }
}

__device__ void modulate_rows(const Ctx& c, const float* x, bf16_t* out, int rows, int rows_per_batch, const float* sh, const float* sc, int bstride) {
    const int c8 = (c.tid & 127) * 8, rstep = c.G * NT / 128;
    for (int b = 0; b * rows_per_batch < rows; ++b) {
        const f32x4 s0 = *(const f32x4*)(sc + b * bstride + c8) + 1.0f, s1 = *(const f32x4*)(sc + b * bstride + c8 + 4) + 1.0f;
        const f32x4 h0 = *(const f32x4*)(sh + b * bstride + c8), h1 = *(const f32x4*)(sh + b * bstride + c8 + 4);
        const int rend = (b + 1) * rows_per_batch;
        for (int r = b * rows_per_batch + ((c.bid * NT + c.tid) >> 7); r < rend; r += rstep) {
            const f32x4 x0 = *(const f32x4*)(x + (size_t)r * D + c8), x1 = *(const f32x4*)(x + (size_t)r * D + c8 + 4);
            const f32x4 y0 = x0 * s0 + h0, y1 = x1 * s1 + h1;
            u32x4 w; w.x = pk2(y0[0], y0[1]); w.y = pk2(y0[2], y0[3]); w.z = pk2(y1[0], y1[1]); w.w = pk2(y1[2], y1[3]);
            *(u32x4*)(out + (size_t)r * D + c8) = w;
        }
    }
}

__device__ void phase_mod0_filt(const Ctx& c) {
    const float* mod0 = c.ws<float>(WS_MOD);
    modulate_rows(c, c.in(I_X), c.ws<bf16_t>(WS_HB), NTOK, SEQ, mod0, mod0 + 1024, 6144);
    const float* modc = c.ws<float>(WS_MODC);
    modulate_rows(c, c.in(I_CTX), c.ws<bf16_t>(WS_HCTX), NCTX, NCTX, modc, modc + 1024, 0);
    {
        const bf16_t* W3T = c.ws<bf16_t>(WS_W3T); const bf16_t* H2 = c.ws<bf16_t>(WS_HID2); bf16_t* FILT = c.ws<bf16_t>(WS_FILT);
        const int l31 = c.lane & 31, hh = c.lane >> 5;
        const float d0 = 3.0701134573253943f, d1 = 15.350567286626972f;
        const int t0 = ((c.bid * 8 + c.wave) & 511) * 32, t = t0 + l31;
        const float tn = (float)t * (1.0f / (float)(SEQ - 1));
        bf16x8 bfr[4];
#pragma unroll
        for (int ks = 0; ks < 4; ++ks) bfr[ks] = *(const bf16x8*)(H2 + (size_t)(t0 + l31) * 64 + ks * 16 + hh * 8);
        for (int item = c.bid * 8 + c.wave; item < 64 * 512; item += c.G * 8) {
            const int col0 = (item >> 9) * 32;
            f32x16 acc;
#pragma unroll
            for (int i = 0; i < 16; ++i) acc[i] = 0.f;
#pragma unroll
            for (int ks = 0; ks < 4; ++ks) {
                const bf16x8 af = *(const bf16x8*)(W3T + (size_t)(col0 + l31) * 64 + ks * 16 + hh * 8);
                acc = __builtin_amdgcn_mfma_f32_32x32x16_bf16(af, bfr[ks], acc, 0, 0, 0);
            }
#pragma unroll
            for (int i = 0; i < 16; ++i) { const int col = col0 + (i & 3) + 8 * (i >> 2) + 4 * hh, ch = col & 1023;
                const float delta = d0 + (float)ch * ((d1 - d0) / 1023.0f);
                const float val = acc[i] * __expf(-tn * delta);
                if (col < 1024) FILT[(size_t)ch * SEQ + t] = (bf16_t)f2bf(val);
                else FILT[(size_t)(1024 + ch) * SEQ + ((SEQ - t) & (SEQ - 1))] = (bf16_t)(t ? f2bf(val) : 0u); }
        }
    }
}

__device__ void phase_attn(const Ctx& c) {
    LAS float* rpb = (LAS float*)c.lds + 64;
    LAS unsigned char* vt = c.lds + 16384 + c.wave * 6144;
    __syncthreads();
    for (int e = c.tid; e < 8 * 15 * 31; e += NT) rpb[e] = c.in(I_RPB)[e] * 1.44269504088896341f;
    __syncthreads();
    const bf16_t* P = c.ws<bf16_t>(WS_BIG);
    const bf16_t* KVC = c.ws<bf16_t>(WS_KVC);
    bf16_t* MIXO = c.ws<bf16_t>(WS_MIX);
    const int lane = c.lane, h = c.wave, l31 = lane & 31, hh = lane >> 5;
    const int gg = lane >> 4, li = lane & 15;
    for (int item = c.bid; item < NBATCH * 256; item += c.G) {
        const int b = item >> 8, r = item & 255;
        const int rs = min(max(r - 4, 0), 248);
        const size_t tok0 = (size_t)b * SEQ + (size_t)r * 64;
        bf16x8 qf[2][4];
#pragma unroll
        for (int nt = 0; nt < 2; ++nt)
#pragma unroll
            for (int s = 0; s < 4; ++s) qf[nt][s] = *(const bf16x8*)(P + (tok0 + nt * 32 + l31) * ABIN + h * 64 + s * 16 + hh * 8);
        f32x16 o[2][2];
#pragma unroll
        for (int nt = 0; nt < 2; ++nt)
#pragma unroll
            for (int mt = 0; mt < 2; ++mt)
#pragma unroll
                for (int i = 0; i < 16; ++i) o[nt][mt][i] = 0.f;
        float mrun[2] = {-1e30f, -1e30f}, lrun[2] = {0.f, 0.f};
        for (int kt = 0; kt < 8; ++kt)
        { constexpr int M_ = 0, C0_ = 0; const int rr = r;
 const size_t row0 = (size_t)b * CTXL + kt * 32; const bf16_t* kbase = KVC + row0 * 1024 + h * 64; const bf16_t* vbase = kbase + 512; const size_t kstride = 1024;
#pragma unroll
            for (int it = 0; it < 4; ++it) { const int key = it * 8 + (lane >> 3), ch = lane & 7;
                const u32x4 v = *(const u32x4*)(vbase + (size_t)key * kstride + ch * 8);
                *(LAS u32x4*)(vt + key * 192 + ch * 16) = v; }
            bf16x8 kf[4];
#pragma unroll
            for (int s = 0; s < 4; ++s) kf[s] = *(const bf16x8*)(kbase + (size_t)l31 * kstride + s * 16 + hh * 8);
            bf16x8 pf[2][2];
#pragma unroll
            for (int nt = 0; nt < 2; ++nt) {
                const bool sparse = M_ != 0 && ((nt == 0) == (C0_ == 32));
                const int e_lo = sparse ? (C0_ == 32 ? 0 : 12) : 0, e_hi = sparse ? e_lo + 4 : 16;
                f32x16 st;
#pragma unroll
                for (int i = 0; i < 16; ++i) st[i] = 0.f;
#pragma unroll
                for (int s = 0; s < 4; ++s) st = __builtin_amdgcn_mfma_f32_32x32x16_bf16(kf[s], qf[nt][s], st, 0, 0, 0);
                float mx = -INFINITY;
                if (M_ == 0) {
#pragma unroll
                    for (int i = 0; i < 16; ++i) { st[i] *= 0.125f * 1.44269504088896341f; mx = fmaxf(mx, st[i]); }
                } else {
                    const int qc = nt * 32 + l31, cs = min(max(qc - 8, 0), 48);
                    const LAS float* rp = rpb + (h * 15 + (rr - r + 7)) * 31 + 15 - qc + C0_ + 4 * hh;
                    unsigned kb = (unsigned)(C0_ + 4 * hh - cs); asm volatile("" : "+v"(kb));
                    float bias[16];
#pragma unroll
                    for (int i = 0; i < 16; ++i) if (i >= e_lo && i < e_hi) bias[i] = rp[(i & 3) + 8 * (i >> 2)];
#pragma unroll
                    for (int i = 0; i < 16; ++i) if (i >= e_lo && i < e_hi) asm volatile("" : "+v"(bias[i]));
#pragma unroll
                    for (int i = 0; i < 16; ++i) if (i >= e_lo && i < e_hi) { const bool valid = (kb + (unsigned)((i & 3) + 8 * (i >> 2))) < 16u;
                        st[i] = valid ? st[i] * (0.125f * 1.44269504088896341f) + bias[i] : -INFINITY; mx = fmaxf(mx, st[i]); }
                }
                mx = fmaxf(mx, sx32(mx, lane));
                if (__builtin_amdgcn_ballot_w64(mx > mrun[nt] + 8.0f) != 0ull) {
                    const float mnew = fmaxf(mrun[nt], mx), alpha = __builtin_amdgcn_exp2f(mrun[nt] - mnew);
                    lrun[nt] *= alpha; mrun[nt] = mnew;
#pragma unroll
                    for (int mt = 0; mt < 2; ++mt)
#pragma unroll
                        for (int i = 0; i < 16; ++i) o[nt][mt][i] *= alpha;
                }
                float ls = 0.f;
#pragma unroll
                for (int i = 0; i < 16; ++i) if (i >= e_lo && i < e_hi) { st[i] = __builtin_amdgcn_exp2f(st[i] - mrun[nt]); ls += st[i]; }
                ls += sx32(ls, lane);
                lrun[nt] += ls;
#pragma unroll
                for (int s2 = 0; s2 < 2; ++s2) if (!sparse || s2 == (e_lo >> 3)) { u32x4 w;
#pragma unroll
                    for (int p = 0; p < 4; ++p) { const int i0 = 8 * s2 + 2 * p; w[p] = (i0 >= e_lo && i0 < e_hi) ? cvt_pk_bf16(st[i0], st[i0 + 1]) : 0u; }
                    pf[nt][s2] = __builtin_bit_cast(bf16x8, w); }
            }
#pragma unroll
            for (int mt = 0; mt < 2; ++mt)
#pragma unroll
                for (int s2 = 0; s2 < 2; ++s2) {
                    const int key0 = 16 * s2 + 4 * hh + (li >> 2), colb = (mt * 32 + 16 * (gg & 1) + 4 * (li & 3)) * 2;
                    const s16x4 lo = __builtin_bit_cast(s16x4, __builtin_amdgcn_ds_read_tr16_b64_v4i16((LAS v4i16_t*)(vt + key0 * 192 + colb)));
                    const s16x4 hi = __builtin_bit_cast(s16x4, __builtin_amdgcn_ds_read_tr16_b64_v4i16((LAS v4i16_t*)(vt + (key0 + 8) * 192 + colb)));
                    bf16x8 vf; vf[0] = lo[0]; vf[1] = lo[1]; vf[2] = lo[2]; vf[3] = lo[3]; vf[4] = hi[0]; vf[5] = hi[1]; vf[6] = hi[2]; vf[7] = hi[3];
#pragma unroll
                    for (int nt = 0; nt < 2; ++nt) { const bool sparse = M_ != 0 && ((nt == 0) == (C0_ == 32)); const int sfull = C0_ == 32 ? 0 : 1;
                        if (!sparse || s2 == sfull) o[nt][mt] = __builtin_amdgcn_mfma_f32_32x32x16_bf16(vf, pf[nt][s2], o[nt][mt], 0, 0, 0); }
                }
        }
        for (int wr = 0; wr < 8; ++wr) { const int rr = rs + wr;
            { constexpr int M_ = 1, C0_ = 0; const size_t row0 = (size_t)b * SEQ + (size_t)rr * 64 + 0; const bf16_t* kbase = P + row0 * ABIN + 512 + h * 64; const bf16_t* vbase = kbase + 512; const size_t kstride = ABIN;
#pragma unroll
                for (int it = 0; it < 4; ++it) { const int key = it * 8 + (lane >> 3), ch = lane & 7;
                    const u32x4 v = *(const u32x4*)(vbase + (size_t)key * kstride + ch * 8);
                    *(LAS u32x4*)(vt + key * 192 + ch * 16) = v; }
                bf16x8 kf[4];
#pragma unroll
                for (int s = 0; s < 4; ++s) kf[s] = *(const bf16x8*)(kbase + (size_t)l31 * kstride + s * 16 + hh * 8);
                bf16x8 pf[2][2];
#pragma unroll
                for (int nt = 0; nt < 2; ++nt) {
                    const bool sparse = M_ != 0 && ((nt == 0) == (C0_ == 32));
                    const int e_lo = sparse ? (C0_ == 32 ? 0 : 12) : 0, e_hi = sparse ? e_lo + 4 : 16;
                    f32x16 st;
#pragma unroll
                    for (int i = 0; i < 16; ++i) st[i] = 0.f;
#pragma unroll
                    for (int s = 0; s < 4; ++s) st = __builtin_amdgcn_mfma_f32_32x32x16_bf16(kf[s], qf[nt][s], st, 0, 0, 0);
                    float mx = -INFINITY;
                    if (M_ == 0) {
#pragma unroll
                        for (int i = 0; i < 16; ++i) { st[i] *= 0.125f * 1.44269504088896341f; mx = fmaxf(mx, st[i]); }
                    } else {
                        const int qc = nt * 32 + l31, cs = min(max(qc - 8, 0), 48);
                        const LAS float* rp = rpb + (h * 15 + (rr - r + 7)) * 31 + 15 - qc + C0_ + 4 * hh;
                        unsigned kb = (unsigned)(C0_ + 4 * hh - cs); asm volatile("" : "+v"(kb));
                        float bias[16];
#pragma unroll
                        for (int i = 0; i < 16; ++i) if (i >= e_lo && i < e_hi) bias[i] = rp[(i & 3) + 8 * (i >> 2)];
#pragma unroll
                        for (int i = 0; i < 16; ++i) if (i >= e_lo && i < e_hi) asm volatile("" : "+v"(bias[i]));
#pragma unroll
                        for (int i = 0; i < 16; ++i) if (i >= e_lo && i < e_hi) { const bool valid = (kb + (unsigned)((i & 3) + 8 * (i >> 2))) < 16u;
                            st[i] = valid ? st[i] * (0.125f * 1.44269504088896341f) + bias[i] : -INFINITY; mx = fmaxf(mx, st[i]); }
                    }
                    mx = fmaxf(mx, sx32(mx, lane));
                    if (__builtin_amdgcn_ballot_w64(mx > mrun[nt] + 8.0f) != 0ull) {
                        const float mnew = fmaxf(mrun[nt], mx), alpha = __builtin_amdgcn_exp2f(mrun[nt] - mnew);
                        lrun[nt] *= alpha; mrun[nt] = mnew;
#pragma unroll
                        for (int mt = 0; mt < 2; ++mt)
#pragma unroll
                            for (int i = 0; i < 16; ++i) o[nt][mt][i] *= alpha;
                    }
                    float ls = 0.f;
#pragma unroll
                    for (int i = 0; i < 16; ++i) if (i >= e_lo && i < e_hi) { st[i] = __builtin_amdgcn_exp2f(st[i] - mrun[nt]); ls += st[i]; }
                    ls += sx32(ls, lane);
                    lrun[nt] += ls;
#pragma unroll
                    for (int s2 = 0; s2 < 2; ++s2) if (!sparse || s2 == (e_lo >> 3)) { u32x4 w;
#pragma unroll
                        for (int p = 0; p < 4; ++p) { const int i0 = 8 * s2 + 2 * p; w[p] = (i0 >= e_lo && i0 < e_hi) ? cvt_pk_bf16(st[i0], st[i0 + 1]) : 0u; }
                        pf[nt][s2] = __builtin_bit_cast(bf16x8, w); }
                }
#pragma unroll
                for (int mt = 0; mt < 2; ++mt)
#pragma unroll
                    for (int s2 = 0; s2 < 2; ++s2) {
                        const int key0 = 16 * s2 + 4 * hh + (li >> 2), colb = (mt * 32 + 16 * (gg & 1) + 4 * (li & 3)) * 2;
                        const s16x4 lo = __builtin_bit_cast(s16x4, __builtin_amdgcn_ds_read_tr16_b64_v4i16((LAS v4i16_t*)(vt + key0 * 192 + colb)));
                        const s16x4 hi = __builtin_bit_cast(s16x4, __builtin_amdgcn_ds_read_tr16_b64_v4i16((LAS v4i16_t*)(vt + (key0 + 8) * 192 + colb)));
                        bf16x8 vf; vf[0] = lo[0]; vf[1] = lo[1]; vf[2] = lo[2]; vf[3] = lo[3]; vf[4] = hi[0]; vf[5] = hi[1]; vf[6] = hi[2]; vf[7] = hi[3];
#pragma unroll
                        for (int nt = 0; nt < 2; ++nt) { const bool sparse = M_ != 0 && ((nt == 0) == (C0_ == 32)); const int sfull = C0_ == 32 ? 0 : 1;
                            if (!sparse || s2 == sfull) o[nt][mt] = __builtin_amdgcn_mfma_f32_32x32x16_bf16(vf, pf[nt][s2], o[nt][mt], 0, 0, 0); }
                    }
            }
            { constexpr int M_ = 2, C0_ = 32; const size_t row0 = (size_t)b * SEQ + (size_t)rr * 64 + 32; const bf16_t* kbase = P + row0 * ABIN + 512 + h * 64; const bf16_t* vbase = kbase + 512; const size_t kstride = ABIN;
#pragma unroll
                for (int it = 0; it < 4; ++it) { const int key = it * 8 + (lane >> 3), ch = lane & 7;
                    const u32x4 v = *(const u32x4*)(vbase + (size_t)key * kstride + ch * 8);
                    *(LAS u32x4*)(vt + key * 192 + ch * 16) = v; }
                bf16x8 kf[4];
#pragma unroll
                for (int s = 0; s < 4; ++s) kf[s] = *(const bf16x8*)(kbase + (size_t)l31 * kstride + s * 16 + hh * 8);
                bf16x8 pf[2][2];
#pragma unroll
                for (int nt = 0; nt < 2; ++nt) {
                    const bool sparse = M_ != 0 && ((nt == 0) == (C0_ == 32));
                    const int e_lo = sparse ? (C0_ == 32 ? 0 : 12) : 0, e_hi = sparse ? e_lo + 4 : 16;
                    f32x16 st;
#pragma unroll
                    for (int i = 0; i < 16; ++i) st[i] = 0.f;
#pragma unroll
                    for (int s = 0; s < 4; ++s) st = __builtin_amdgcn_mfma_f32_32x32x16_bf16(kf[s], qf[nt][s], st, 0, 0, 0);
                    float mx = -INFINITY;
                    if (M_ == 0) {
#pragma unroll
                        for (int i = 0; i < 16; ++i) { st[i] *= 0.125f * 1.44269504088896341f; mx = fmaxf(mx, st[i]); }
                    } else {
                        const int qc = nt * 32 + l31, cs = min(max(qc - 8, 0), 48);
                        const LAS float* rp = rpb + (h * 15 + (rr - r + 7)) * 31 + 15 - qc + C0_ + 4 * hh;
                        unsigned kb = (unsigned)(C0_ + 4 * hh - cs); asm volatile("" : "+v"(kb));
                        float bias[16];
#pragma unroll
                        for (int i = 0; i < 16; ++i) if (i >= e_lo && i < e_hi) bias[i] = rp[(i & 3) + 8 * (i >> 2)];
#pragma unroll
                        for (int i = 0; i < 16; ++i) if (i >= e_lo && i < e_hi) asm volatile("" : "+v"(bias[i]));
#pragma unroll
                        for (int i = 0; i < 16; ++i) if (i >= e_lo && i < e_hi) { const bool valid = (kb + (unsigned)((i & 3) + 8 * (i >> 2))) < 16u;
                            st[i] = valid ? st[i] * (0.125f * 1.44269504088896341f) + bias[i] : -INFINITY; mx = fmaxf(mx, st[i]); }
                    }
                    mx = fmaxf(mx, sx32(mx, lane));
                    if (__builtin_amdgcn_ballot_w64(mx > mrun[nt] + 8.0f) != 0ull) {
                        const float mnew = fmaxf(mrun[nt], mx), alpha = __builtin_amdgcn_exp2f(mrun[nt] - mnew);
                        lrun[nt] *= alpha; mrun[nt] = mnew;
#pragma unroll
                        for (int mt = 0; mt < 2; ++mt)
#pragma unroll
                            for (int i = 0; i < 16; ++i) o[nt][mt][i] *= alpha;
                    }
                    float ls = 0.f;
#pragma unroll
                    for (int i = 0; i < 16; ++i) if (i >= e_lo && i < e_hi) { st[i] = __builtin_amdgcn_exp2f(st[i] - mrun[nt]); ls += st[i]; }
                    ls += sx32(ls, lane);
                    lrun[nt] += ls;
#pragma unroll
                    for (int s2 = 0; s2 < 2; ++s2) if (!sparse || s2 == (e_lo >> 3)) { u32x4 w;
#pragma unroll
                        for (int p = 0; p < 4; ++p) { const int i0 = 8 * s2 + 2 * p; w[p] = (i0 >= e_lo && i0 < e_hi) ? cvt_pk_bf16(st[i0], st[i0 + 1]) : 0u; }
                        pf[nt][s2] = __builtin_bit_cast(bf16x8, w); }
                }
#pragma unroll
                for (int mt = 0; mt < 2; ++mt)
#pragma unroll
                    for (int s2 = 0; s2 < 2; ++s2) {
                        const int key0 = 16 * s2 + 4 * hh + (li >> 2), colb = (mt * 32 + 16 * (gg & 1) + 4 * (li & 3)) * 2;
                        const s16x4 lo = __builtin_bit_cast(s16x4, __builtin_amdgcn_ds_read_tr16_b64_v4i16((LAS v4i16_t*)(vt + key0 * 192 + colb)));
                        const s16x4 hi = __builtin_bit_cast(s16x4, __builtin_amdgcn_ds_read_tr16_b64_v4i16((LAS v4i16_t*)(vt + (key0 + 8) * 192 + colb)));
                        bf16x8 vf; vf[0] = lo[0]; vf[1] = lo[1]; vf[2] = lo[2]; vf[3] = lo[3]; vf[4] = hi[0]; vf[5] = hi[1]; vf[6] = hi[2]; vf[7] = hi[3];
#pragma unroll
                        for (int nt = 0; nt < 2; ++nt) { const bool sparse = M_ != 0 && ((nt == 0) == (C0_ == 32)); const int sfull = C0_ == 32 ? 0 : 1;
                            if (!sparse || s2 == sfull) o[nt][mt] = __builtin_amdgcn_mfma_f32_32x32x16_bf16(vf, pf[nt][s2], o[nt][mt], 0, 0, 0); }
                    }
            }
        }
#pragma unroll
        for (int nt = 0; nt < 2; ++nt) {
            const float inv = 1.0f / lrun[nt];
            bf16_t* op = MIXO + (tok0 + nt * 32 + l31) * D + h * 64;
#pragma unroll
            for (int mt = 0; mt < 2; ++mt)
#pragma unroll
                for (int gi = 0; gi < 4; ++gi) { u32x2 w; w.x = cvt_pk_bf16(o[nt][mt][4 * gi] * inv, o[nt][mt][4 * gi + 1] * inv); w.y = cvt_pk_bf16(o[nt][mt][4 * gi + 2] * inv, o[nt][mt][4 * gi + 3] * inv);
                    *(u32x2*)(op + mt * 32 + 8 * gi + 4 * hh) = w; }
        }
    }
    __syncthreads();
}

__device__ void phase_gating(const Ctx& c) {
    constexpr int RS = 1088;
    const bf16_t* P = c.ws<bf16_t>(WS_BIG);
    bf16_t* MIXO = c.ws<bf16_t>(WS_MIX);
    const bf16_t* WS = c.ws<bf16_t>(WS_WS_BF);
    const float* BS = c.in(I_GMBS);
    const int lane = c.lane, l31 = lane & 31, hh = lane >> 5, gg = lane >> 4, li = lane & 15;
    for (int item = c.bid; item < NTOK / 128; item += c.G) {
        const size_t tok0 = (size_t)item * 128;
        __syncthreads();
        for (int rw = 0; rw < 16; ++rw) {
            const int row = c.wave * 16 + rw;
            const u32x4 raw = *(const u32x4*)(P + (tok0 + row) * ABIN + 2048 + lane * 8);
            float v[8]; v[0] = bf2f(raw.x); v[1] = bf2f(raw.x >> 16); v[2] = bf2f(raw.y); v[3] = bf2f(raw.y >> 16); v[4] = bf2f(raw.z); v[5] = bf2f(raw.z >> 16); v[6] = bf2f(raw.w); v[7] = bf2f(raw.w >> 16);
            float s = 0.f;
#pragma unroll
            for (int i = 0; i < 8; ++i) s += v[i];
            const float mean = wave_sum(s, lane) * (1.0f / 512.0f);
            float q = 0.f;
#pragma unroll
            for (int i = 0; i < 8; ++i) { v[i] -= mean; q += v[i] * v[i]; }
            const float rstd = rsqrtf(wave_sum(q, lane) * (1.0f / 512.0f) + LN_EPS);
            u32x4 w; w.x = pk2(v[0] * rstd, v[1] * rstd); w.y = pk2(v[2] * rstd, v[3] * rstd); w.z = pk2(v[4] * rstd, v[5] * rstd); w.w = pk2(v[6] * rstd, v[7] * rstd);
            *(LAS u32x4*)(c.lds + row * RS + lane * 16) = w;
        }
        __syncthreads();
        const int g = c.wave >> 1, ph = c.wave & 1;
        f32x16 acc[2][4];
#pragma unroll
        for (int mt = 0; mt < 2; ++mt)
#pragma unroll
            for (int ct = 0; ct < 4; ++ct)
#pragma unroll
                for (int i = 0; i < 16; ++i) acc[mt][ct][i] = 0.f;
        for (int ks = 0; ks < 8; ++ks) {
            bf16x8 af[2];
#pragma unroll
            for (int mt = 0; mt < 2; ++mt) af[mt] = *(const bf16x8*)(WS + ((size_t)g * 128 + ph * 64 + mt * 32 + l31) * 128 + ks * 16 + hh * 8);
#pragma unroll
            for (int ct = 0; ct < 4; ++ct) {
                const int q0 = 16 * ks + 8 * hh + (li >> 2), colb = (g * 128 + ct * 32 + 16 * (gg & 1) + 4 * (li & 3)) * 2;
                const s16x4 lo = __builtin_bit_cast(s16x4, __builtin_amdgcn_ds_read_tr16_b64_v4i16((LAS v4i16_t*)(c.lds + q0 * RS + colb)));
                const s16x4 hi = __builtin_bit_cast(s16x4, __builtin_amdgcn_ds_read_tr16_b64_v4i16((LAS v4i16_t*)(c.lds + (q0 + 4) * RS + colb)));
                bf16x8 bfr; bfr[0] = lo[0]; bfr[1] = lo[1]; bfr[2] = lo[2]; bfr[3] = lo[3]; bfr[4] = hi[0]; bfr[5] = hi[1]; bfr[6] = hi[2]; bfr[7] = hi[3];
#pragma unroll
                for (int mt = 0; mt < 2; ++mt) acc[mt][ct] = __builtin_amdgcn_mfma_f32_32x32x16_bf16(bfr, af[mt], acc[mt][ct], 0, 0, 0);
            }
        }
#pragma unroll
        for (int mt = 0; mt < 2; ++mt) {
            const int p = ph * 64 + mt * 32 + l31;
            const float bs = BS[g * 128 + p];
#pragma unroll
            for (int ct = 0; ct < 4; ++ct)
#pragma unroll
                for (int gi = 0; gi < 4; ++gi) {
                    const int col = g * 128 + ct * 32 + 8 * gi + 4 * hh;
                    const u32x2 uu = *(const u32x2*)(P + (tok0 + p) * ABIN + 1536 + col);
                    u32x2 w; w.x = pk2(bf2f(uu.x) * (acc[mt][ct][4 * gi] + bs), bf2f(uu.x >> 16) * (acc[mt][ct][4 * gi + 1] + bs));
                    w.y = pk2(bf2f(uu.y) * (acc[mt][ct][4 * gi + 2] + bs), bf2f(uu.y >> 16) * (acc[mt][ct][4 * gi + 3] + bs));
                    *(u32x2*)(MIXO + (tok0 + p) * D + 512 + col) = w;
                }
        }
    }
    __syncthreads();
}

template <int CM = 0> __device__ __forceinline__ void ln_row(float (&v)[16], const float* g, const float* b, int lane) {
    float s = 0.f;
#pragma unroll
    for (int i = 0; i < 16; ++i) s += v[i];
    const float mean = wave_sum(s, lane) * (1.0f / 1024.0f);
    float q = 0.f;
#pragma unroll
    for (int i = 0; i < 16; ++i) { v[i] -= mean; q += v[i] * v[i]; }
    const float rstd = rsqrtf(wave_sum(q, lane) * (1.0f / 1024.0f) + LN_EPS);
#pragma unroll
    for (int m = 0; m < 4; ++m) { const int col = CM == 3 ? 128 * (4 * (lane >> 5) + m) + 4 * (lane & 31) : (CM == 2 ? 32 * (lane & 31) + 16 * (lane >> 5) + 4 * m : (CM == 1 ? 16 * lane + 4 * m : 256 * m + 4 * lane)); const f32x4 gv = *(const f32x4*)(g + col), bv = *(const f32x4*)(b + col);
#pragma unroll
        for (int e = 0; e < 4; ++e) v[4 * m + e] = v[4 * m + e] * rstd * gv[e] + bv[e]; }
}
template <int CM = 0> __device__ __forceinline__ void store_mod_bf16(const float (&v)[16], bf16_t* dst, const float* sh, const float* sc, int lane) {
#pragma unroll
    for (int m = 0; m < 4; ++m) { const int col = CM == 3 ? 128 * (4 * (lane >> 5) + m) + 4 * (lane & 31) : (CM == 2 ? 32 * (lane & 31) + 16 * (lane >> 5) + 4 * m : (CM == 1 ? 16 * lane + 4 * m : 256 * m + 4 * lane)); const f32x4 s = *(const f32x4*)(sc + col), h = *(const f32x4*)(sh + col);
        u32x2 w; w.x = pk2(v[4 * m] * (1.0f + s[0]) + h[0], v[4 * m + 1] * (1.0f + s[1]) + h[1]); w.y = pk2(v[4 * m + 2] * (1.0f + s[2]) + h[2], v[4 * m + 3] * (1.0f + s[3]) + h[3]);
        *(u32x2*)(dst + col) = w; }
}

__device__ __forceinline__ bf16_t* resid_buf(const Ctx& c, int which) { return which < 2 ? (bf16_t*)c.a->out + (size_t)which * NTOK * D : c.ws<bf16_t>(WS_MIX); }
__device__ void phase_ln1(const Ctx& c, int layer) {
    bf16_t* HQ = c.ws<bf16_t>(WS_HB); const bf16_t* Y = c.ws<bf16_t>(WS_BIG);
    const float* resf = c.in(I_X); const bf16_t* resb = resid_buf(c, 1); bf16_t* XO = resid_buf(c, layer == 0 ? 0 : 2);
    const float* g = c.in(I_LNG) + (layer * 2 + 0) * D; const float* b = c.in(I_LNB) + (layer * 2 + 0) * D;
    f32x4 gv[4], bv[4], g1v[4], shv[4], scv[4]; int curb = -1;
#pragma unroll
    for (int m = 0; m < 4; ++m) { const int col = 256 * m + 4 * c.lane; gv[m] = *(const f32x4*)(g + col); bv[m] = *(const f32x4*)(b + col); }
    for (int row0 = (c.bid * 8 + c.wave) * 2; row0 < NTOK; row0 += c.G * 8 * 2) {
        const int bt = row0 / SEQ;
        if (bt != curb) { curb = bt; const float* mod = c.ws<float>(WS_MOD) + (layer * 2 + bt) * 6144;
#pragma unroll
            for (int m = 0; m < 4; ++m) { const int col = 256 * m + 4 * c.lane; g1v[m] = *(const f32x4*)(mod + 2 * 1024 + col); shv[m] = *(const f32x4*)(mod + 3 * 1024 + col); scv[m] = *(const f32x4*)(mod + 4 * 1024 + col) + 1.0f; } }
        float v[2][16];
#pragma unroll
        for (int q = 0; q < 2; ++q)
#pragma unroll
            for (int m = 0; m < 4; ++m) { const int col = 256 * m + 4 * c.lane; const f32x4 g1 = g1v[m];
                f32x4 t;
                if (layer == 0) t = *(const f32x4*)(resf + (size_t)(row0 + q) * D + col);
                else { const u32x2 tb = *(const u32x2*)(resb + (size_t)(row0 + q) * D + col); t = (f32x4){bf2f(tb[0]), bf2f(tb[0] >> 16), bf2f(tb[1]), bf2f(tb[1] >> 16)}; }
                const u32x2 yy = *(const u32x2*)(Y + (size_t)(row0 + q) * D + col);
                v[q][4 * m] = DN_ALPHA * t[0] + g1[0] * bf2f(yy[0]); v[q][4 * m + 1] = DN_ALPHA * t[1] + g1[1] * bf2f(yy[0] >> 16);
                v[q][4 * m + 2] = DN_ALPHA * t[2] + g1[2] * bf2f(yy[1]); v[q][4 * m + 3] = DN_ALPHA * t[3] + g1[3] * bf2f(yy[1] >> 16); }
#pragma unroll
        for (int q = 0; q < 2; ++q) {
            float sm = 0.f;
#pragma unroll
            for (int i = 0; i < 16; ++i) sm += v[q][i];
            const float mean = wave_sum(sm, c.lane) * (1.0f / 1024.0f);
            float qs = 0.f;
#pragma unroll
            for (int i = 0; i < 16; ++i) { v[q][i] -= mean; qs += v[q][i] * v[q][i]; }
            const float rstd = rsqrtf(wave_sum(qs, c.lane) * (1.0f / 1024.0f) + LN_EPS);
#pragma unroll
            for (int m = 0; m < 4; ++m) { const int col = 256 * m + 4 * c.lane; f32x4 o_;
#pragma unroll
                for (int e = 0; e < 4; ++e) o_[e] = v[q][4 * m + e] * rstd * gv[m][e] + bv[m][e];
                *(u32x2*)(XO + (size_t)(row0 + q) * D + col) = (u32x2){pk2(o_[0], o_[1]), pk2(o_[2], o_[3])};
                const f32x4 hq = o_ * scv[m] + shv[m];
                *(u32x2*)(HQ + (size_t)(row0 + q) * D + col) = (u32x2){pk2(hq[0], hq[1]), pk2(hq[2], hq[3])}; }
        }
    }
}

__device__ __forceinline__ void ce_desc(unsigned& a, unsigned& b) { const unsigned hi = a > b ? a : b, lo = a > b ? b : a; a = hi; b = lo; }
__device__ __forceinline__ void sort16_desc(unsigned (&v)[16]) {
#pragma unroll
    for (int k = 2; k <= 16; k <<= 1)
#pragma unroll
        for (int j = k >> 1; j > 0; j >>= 1)
#pragma unroll
            for (int i = 0; i < 16; ++i) { const int l = i ^ j; if (l > i) { if ((i & k) == 0) ce_desc(v[i], v[l]); else ce_desc(v[l], v[i]); } }
}
__device__ __forceinline__ void bitonic_merge16_desc(unsigned (&v)[16]) {
#pragma unroll
    for (int j = 8; j > 0; j >>= 1)
#pragma unroll
        for (int i = 0; i < 16; ++i) { const int l = i ^ j; if (l > i) ce_desc(v[i], v[l]); }
}
__device__ __forceinline__ void merge_top16(unsigned (&L)[16], unsigned (&C)[16]) {
    sort16_desc(C);
#pragma unroll
    for (int i = 0; i < 16; ++i) L[i] = L[i] > C[15 - i] ? L[i] : C[15 - i];
    bitonic_merge16_desc(L);
}
__device__ __forceinline__ unsigned f32_sortable(float f) { const unsigned u = __builtin_bit_cast(unsigned, f); return u ^ ((u >> 31) ? 0xFFFFFFFFu : 0x80000000u); }
__device__ void phase_topk(const Ctx& c) {
    const _Float16* S = c.ws<_Float16>(WS_BIG);
    unsigned short* IDX = c.ws<unsigned short>(WS_IDX);
    float* GATE = c.ws<float>(WS_GATE);
    LAS unsigned char* wl = c.lds + c.wave * 17408;
    LAS unsigned char* ib = c.lds + 139264 + c.tid * 32;
    const int lane = c.lane;
    for (int blk = c.bid; blk < NTOK * 8 / NT; blk += c.G) {
        const int it0 = blk * NT + c.wave * 64;
        float val[2][16];
#pragma unroll
        for (int part = 0; part < 2; ++part) {
#pragma unroll
            for (int i = 0; i < 16; ++i) { const int row = i * 4 + (lane >> 4), ch = lane & 15, item = it0 + row;
                const u32x4 v = *(const u32x4*)(S + (size_t)(item >> 3) * PQN + (item & 7) * 256 + part * 128 + ch * 8);
                *(LAS u32x4*)(wl + row * 272 + ch * 16) = v; }
            unsigned L[16];
#pragma unroll 1
            for (int q = 0; q < 8; ++q) {
                const u32x4 w0 = *(const LAS u32x4*)(wl + lane * 272 + q * 32), w1 = *(const LAS u32x4*)(wl + lane * 272 + q * 32 + 16);
                const unsigned w[8] = {w0.x, w0.y, w0.z, w0.w, w1.x, w1.y, w1.z, w1.w};
                unsigned C[16];
#pragma unroll
                for (int e = 0; e < 16; ++e) { const unsigned hb = (e & 1) ? (w[e >> 1] >> 16) : (w[e >> 1] & 0xffffu);
                    const unsigned sk = hb ^ ((hb & 0x8000u) ? 0xffffu : 0x8000u);
                    C[e] = (sk << 16) | (unsigned)(127 - (q * 16 + e)); }
                if (q == 0) {
#pragma unroll
                    for (int e = 0; e < 16; ++e) L[e] = 0u; }
                merge_top16(L, C);
            }
#pragma unroll
            for (int e = 0; e < 16; ++e) { const unsigned sk = L[e] >> 16, hb = sk ^ ((sk & 0x8000u) ? 0x8000u : 0xffffu);
                val[part][e] = (float)__builtin_bit_cast(_Float16, (unsigned short)hb);
                ib[part * 16 + e] = (unsigned char)(127u - (L[e] & 127u)); }
        }
        unsigned T[16];
#pragma unroll
        for (int j = 0; j < 16; ++j) T[j] = (f32_sortable(val[0][0] + val[1][j]) & 0xffffff00u) | (unsigned)(255 - j);
        {
            unsigned C[16]; int n = 0;
#pragma unroll
            for (int i = 1; i < 16; ++i)
#pragma unroll
                for (int j = 0; j < 16; ++j) if ((i + 1) * (j + 1) <= 16) {
                    const unsigned key = (f32_sortable(val[0][i] + val[1][j]) & 0xffffff00u) | (unsigned)(255 - (16 * i + j));
                    if (n < 32) { C[n & 15] = key; if ((n & 15) == 15) merge_top16(T, C); }
                    else { unsigned x = key;
#pragma unroll
                        for (int k = 0; k < 16; ++k) { const unsigned hi = T[k] > x ? T[k] : x; x = T[k] > x ? x : T[k]; T[k] = hi; } }
                    ++n; }
        }
        float gv[16]; int id[16]; float sum = 0.f, mx;
        { const unsigned sk = T[0] & 0xffffff00u; mx = __builtin_bit_cast(float, (sk & 0x80000000u) ? (sk ^ 0x80000000u) : ~sk); }
#pragma unroll
        for (int k = 0; k < 16; ++k) { const unsigned sk = T[k] & 0xffffff00u, flat = 255u - (T[k] & 255u);
            const float v = __builtin_bit_cast(float, (sk & 0x80000000u) ? (sk ^ 0x80000000u) : ~sk);
            gv[k] = __expf(v - mx); sum += gv[k];
            id[k] = (int)ib[flat >> 4] * 128 + (int)ib[16 + (flat & 15)]; }
        const float inv = 1.0f / sum;
        const size_t o = (size_t)(blk * NT + c.tid) * 16;
#pragma unroll
        for (int q = 0; q < 2; ++q) { u32x4 w; w.x = id[8 * q] | (id[8 * q + 1] << 16); w.y = id[8 * q + 2] | (id[8 * q + 3] << 16); w.z = id[8 * q + 4] | (id[8 * q + 5] << 16); w.w = id[8 * q + 6] | (id[8 * q + 7] << 16);
            *(u32x4*)(IDX + o + 8 * q) = w; }
#pragma unroll
        for (int q = 0; q < 4; ++q) *(f32x4*)(GATE + o + 4 * q) = (f32x4){gv[4 * q] * inv, gv[4 * q + 1] * inv, gv[4 * q + 2] * inv, gv[4 * q + 3] * inv};
    }
}

typedef float v32f __attribute__((ext_vector_type(32)));
typedef unsigned v6u_t __attribute__((ext_vector_type(6)));
typedef unsigned u32x4a8 __attribute__((ext_vector_type(4), aligned(8)));
typedef _Float16 v32h_t __attribute__((ext_vector_type(32)));
typedef _Float16 v2h_t __attribute__((ext_vector_type(2)));
constexpr int NSL = 2;
__device__ void phase_gather_u(const Ctx& c, int layer) {
    const bf16_t* HQ = c.ws<bf16_t>(WS_HB);
    const unsigned short* IDX = c.ws<unsigned short>(WS_IDX);
    float* PART = c.ws<float>(WS_BIG);
    const int lane = c.lane, r16 = lane & 15, g = lane >> 4;
    const int h = (c.bid & 7) >> 2, r = 16 * h + r16;
    const unsigned char* U6 = c.ws<unsigned char>(WS_TAB8) + (size_t)(layer * 2 + 0) * 16384 * 768 + 24 * r;
    const bool b3 = lane & 8, b2 = lane & 4, b1 = lane & 2;
    const int jmine = 4 * (int)b3 + 2 * (int)b2 + (int)b1;
    const int nblk = c.G >> 1, blk = (c.bid >> 3) * 4 + (c.bid & 3);
    const int tstep = nblk * 8;
#define GU_LOAD_TOK(t_, hq_, i0_, i1_) do { const int t__ = (t_) < NTOK ? (t_) : NTOK - 1; \
        _Pragma("unroll") for (int m = 0; m < 8; ++m) hq_[m] = *(const u32x2*)(HQ + (size_t)t__ * D + 128 * m + 4 * r); \
        i0_ = IDX[(size_t)t__ * 128 + lane]; i1_ = IDX[(size_t)t__ * 128 + 64 + lane]; } while (0)
#define GU_ISSUE(i0_, i1_, ch_, a4_, a2_) do { _Pragma("unroll") for (int j = 0; j < 8; ++j) { const int id = lane_geti((ch_) < 2 ? i0_ : i1_, (32 * (ch_) + 4 * j + g) & 63); const unsigned char* up = U6 + __umul24((unsigned)id, 768u); \
        a4_[j] = *(const u32x4a8*)up; a2_[j] = *(const u32x2*)(up + 16); } } while (0)
#define GU_COMPUTE(a4_, a2_, ch_, t_) do { float p[8]; \
        _Pragma("unroll") for (int j = 0; j < 8; ++j) { const v6u_t q = {a4_[j][0], a4_[j][1], a4_[j][2], a4_[j][3], a2_[j][0], a2_[j][1]}; \
            const v32h_t f = __builtin_amdgcn_cvt_scalef32_pk32_f16_fp6(q, 1.0f); float sdot = 0.f;     \
            _Pragma("unroll") for (int i = 0; i < 16; ++i) sdot = __builtin_amdgcn_fdot2((v2h_t){f[2 * i], f[2 * i + 1]}, xh[i], sdot, false); \
            p[j] = sdot; } \
        float r2[4], r3[2], r4;     \
        _Pragma("unroll") for (int k = 0; k < 4; ++k) { const float send = b3 ? p[k] : p[k + 4], keep = b3 ? p[k + 4] : p[k]; r2[k] = keep + dppx<0x128>(send); }     \
        _Pragma("unroll") for (int k = 0; k < 2; ++k) { const float send = b2 ? r2[k] : r2[k + 2], keep = b2 ? r2[k + 2] : r2[k]; r3[k] = keep + dppx<0x141>(send); }     \
        { const float send = b1 ? r3[0] : r3[1], keep = b1 ? r3[1] : r3[0]; r4 = keep + dppx<0x4E>(send); }     \
        r4 += dppx<0xB1>(r4);     \
        if ((t_) < NTOK && (lane & 1) == 0) PART[((size_t)(t_) * NSL + h) * 128 + 32 * (ch_) + 4 * jmine + g] = r4; } while (0)
    int tok = blk * 8 + c.wave;
    u32x2 hqc[8], hqn[8]; int ic0, ic1, in0, in1;
    u32x4 ra4[8], rb4[8]; u32x2 ra2[8], rb2[8];
    GU_LOAD_TOK(tok, hqc, ic0, ic1);
    GU_ISSUE(ic0, ic1, 0, ra4, ra2);
#pragma unroll 1
    for (; tok < NTOK; tok += tstep) {
        v2h_t xh[16];
#pragma unroll
        for (int m = 0; m < 8; ++m)
#pragma unroll
            for (int e = 0; e < 2; ++e) xh[2 * m + e] = __builtin_bit_cast(v2h_t, __builtin_amdgcn_cvt_pkrtz(bf2f(hqc[m][e]), bf2f(hqc[m][e] >> 16)));
        GU_LOAD_TOK(tok + tstep, hqn, in0, in1);
        GU_ISSUE(ic0, ic1, 1, rb4, rb2); GU_COMPUTE(ra4, ra2, 0, tok);
        GU_ISSUE(ic0, ic1, 2, ra4, ra2); GU_COMPUTE(rb4, rb2, 1, tok);
        GU_ISSUE(ic0, ic1, 3, rb4, rb2); GU_COMPUTE(ra4, ra2, 2, tok);
        GU_ISSUE(in0, in1, 0, ra4, ra2); GU_COMPUTE(rb4, rb2, 3, tok);
#pragma unroll
        for (int m = 0; m < 8; ++m) hqc[m] = hqn[m];
        ic0 = in0; ic1 = in1;
    }
#undef GU_LOAD_TOK
#undef GU_ISSUE
#undef GU_COMPUTE
}
__device__ void phase_gather_v(const Ctx& c, int layer) {
    float* X = c.a->out; const bf16_t* XI = resid_buf(c, layer == 0 ? 0 : 2); bf16_t* XO = resid_buf(c, 1);
    const unsigned short* IDX = c.ws<unsigned short>(WS_IDX);
    const float* GATE = c.ws<float>(WS_GATE); const float* PART = c.ws<float>(WS_BIG);
    const f32x2* DQ2 = c.ws<f32x2>(WS_DQ) + (size_t)layer * 16384;
    const unsigned char* V6 = c.ws<unsigned char>(WS_TAB8) + (size_t)(layer * 2 + 1) * 16384 * 768;
    const float* g = c.in(I_LNG) + (layer * 2 + 1) * D; const float* b = c.in(I_LNB) + (layer * 2 + 1) * D;
    const int lane = c.lane, hh = lane >> 5, r = lane & 31;
    const unsigned char* V6r = V6 + 24 * r;
    const int tstep = c.G * 8;
#define GV_ISSUE(isel_, wsel_, ch_, a4_, a2_, wj_) do { _Pragma("unroll") for (int j = 0; j < 4; ++j) { const int sl_ = (8 * (ch_) + 2 * j + hh) & 63; const int id = lane_geti(isel_, sl_); \
        { const float wf_ = lane_get(wsel_, sl_); wj_[j] = __builtin_bit_cast(v2h_t, __builtin_amdgcn_cvt_pkrtz(wf_, wf_)); } \
        const unsigned char* vp = V6r + __umul24((unsigned)id, 768u); a4_[j] = *(const u32x4a8*)vp; a2_[j] = *(const u32x2*)(vp + 16); } } while (0)
#define GV_COMPUTE(a4_, a2_, wj_) do { _Pragma("unroll") for (int j = 0; j < 4; ++j) { const v6u_t wv = {a4_[j][0], a4_[j][1], a4_[j][2], a4_[j][3], a2_[j][0], a2_[j][1]}; \
        const v32h_t f = __builtin_amdgcn_cvt_scalef32_pk32_f16_fp6(wv, 1.0f);     \
        _Pragma("unroll") for (int i = 0; i < 16; ++i) acc2[i] = __builtin_elementwise_fma((v2h_t){f[2 * i], f[2 * i + 1]}, wj_[j], acc2[i]);     \
        __builtin_amdgcn_sched_barrier(0); } } while (0)
#define GV_PAIR(cp_) do { { const int ch_ = 2 * (cp_) + 1; GV_ISSUE((ch_ < 8 ? id0 : id1), (ch_ < 8 ? w0 : w1), ch_, rb4, rb2, wb); } \
        GV_COMPUTE(ra4, ra2, wa); \
        { const int ch_ = (2 * (cp_) + 2) & 15; const bool nx_ = (cp_) == 7; GV_ISSUE((nx_ ? idn0 : (ch_ < 8 ? id0 : id1)), (nx_ ? wn0 : (ch_ < 8 ? w0 : w1)), ch_, ra4, ra2, wa); } \
        GV_COMPUTE(rb4, rb2, wb); } while (0)
#define GV_WEIGHTS(t_, i0_, i1_, o0_, o1_) do { const f32x2 dq0 = DQ2[i0_], dq1 = DQ2[i1_]; const float g0 = GATE[(size_t)(t_) * 128 + lane], g1 = GATE[(size_t)(t_) * 128 + 64 + lane]; \
        float s0 = 0.f, s1 = 0.f; \
        _Pragma("unroll") for (int sl = 0; sl < NSL; ++sl) { s0 += PART[((size_t)(t_) * NSL + sl) * 128 + lane]; s1 += PART[((size_t)(t_) * NSL + sl) * 128 + 64 + lane]; } \
        o0_ = gelu_erf(s0 * dq0[0]) * (g0 * dq0[1]); o1_ = gelu_erf(s1 * dq1[0]) * (g1 * dq1[1]); } while (0)
#define GV_NORM(o0_, o1_, mx_) do { mx_ = wave_max(fmaxf(fabsf(o0_), fabsf(o1_)), lane); const float inv_ = mx_ > 0.f ? 1.0f / mx_ : 0.f; o0_ *= inv_; o1_ *= inv_; } while (0)
    f32x4 gmv[4], btv[4], g2v[4], shv[4], scv[4]; int curb = -1;
#pragma unroll
    for (int m = 0; m < 4; ++m) { const int col = 128 * (4 * hh + m) + 4 * r; gmv[m] = *(const f32x4*)(g + col); btv[m] = *(const f32x4*)(b + col); }
    int tok = c.bid * 8 + c.wave;
    int id0 = 0, id1 = 0, idn0, idn1; float w0 = 0.f, w1 = 0.f, wn0, wn1;
    u32x4 ra4[4], rb4[4]; u32x2 ra2[4], rb2[4]; v2h_t wa[4], wb[4]; float wmax = 0.f, wmaxn;
    if (tok < NTOK) { id0 = IDX[(size_t)tok * 128 + lane]; id1 = IDX[(size_t)tok * 128 + 64 + lane]; GV_WEIGHTS(tok, id0, id1, w0, w1); GV_NORM(w0, w1, wmax); }
    GV_ISSUE(id0, w0, 0, ra4, ra2, wa);
#pragma unroll 1
    for (; tok < NTOK; tok += tstep) {
        const int bt = tok / SEQ;
        if (bt != curb) { curb = bt; const float* mod = c.ws<float>(WS_MOD) + (layer * 2 + bt) * 6144; const float* mod1 = c.ws<float>(WS_MOD) + (2 + bt) * 6144;
#pragma unroll
            for (int m = 0; m < 4; ++m) { const int col = 128 * (4 * hh + m) + 4 * r; g2v[m] = *(const f32x4*)(mod + 5 * 1024 + col);
                if (layer == 0) { shv[m] = *(const f32x4*)(mod1 + col); scv[m] = *(const f32x4*)(mod1 + 1024 + col) + 1.0f; } } }
        const int tn = tok + tstep < NTOK ? tok + tstep : tok;
        v2h_t acc2[16];
#pragma unroll
        for (int i = 0; i < 16; ++i) acc2[i] = (v2h_t){(_Float16)0.f, (_Float16)0.f};
        idn0 = IDX[(size_t)tn * 128 + lane]; idn1 = IDX[(size_t)tn * 128 + 64 + lane];
        const float gn0 = GATE[(size_t)tn * 128 + lane], gn1 = GATE[(size_t)tn * 128 + 64 + lane];
        float sn0 = 0.f, sn1 = 0.f; float pn[2 * NSL];
#pragma unroll
        for (int sl = 0; sl < NSL; ++sl) { pn[2 * sl] = PART[((size_t)tn * NSL + sl) * 128 + lane]; pn[2 * sl + 1] = PART[((size_t)tn * NSL + sl) * 128 + 64 + lane]; }
#pragma unroll 1
        for (int cp = 0; cp < 2; ++cp) GV_PAIR(cp);
        const f32x2 dqn0 = DQ2[idn0], dqn1 = DQ2[idn1];
#pragma unroll 1
        for (int cp = 2; cp < 6; ++cp) GV_PAIR(cp);
#pragma unroll
        for (int sl = 0; sl < NSL; ++sl) { sn0 += pn[2 * sl]; sn1 += pn[2 * sl + 1]; }
        wn0 = gelu_erf(sn0 * dqn0[0]) * (gn0 * dqn0[1]); wn1 = gelu_erf(sn1 * dqn1[0]) * (gn1 * dqn1[1]); GV_NORM(wn0, wn1, wmaxn);
        u32x2 x1q[4];
#pragma unroll
        for (int m = 0; m < 4; ++m) x1q[m] = *(const u32x2*)(XI + (size_t)tok * D + 128 * (4 * hh + m) + 4 * r);
#pragma unroll 1
        for (int cp = 6; cp < 8; ++cp) GV_PAIR(cp);
        float y[16];
#pragma unroll
        for (int k = 0; k < 8; ++k) { const v2h_t send = hh ? acc2[k] : acc2[8 + k], keep = hh ? acc2[8 + k] : acc2[k];
            const v2h_t got = __builtin_bit_cast(v2h_t, lane_geti(__builtin_bit_cast(int, send), lane ^ 32));
            y[2 * k] = ((float)keep[0] + (float)got[0]) * wmax; y[2 * k + 1] = ((float)keep[1] + (float)got[1]) * wmax; }
#pragma unroll
        for (int m = 0; m < 4; ++m) { const f32x4 g2 = g2v[m], x1 = (f32x4){bf2f(x1q[m][0]), bf2f(x1q[m][0] >> 16), bf2f(x1q[m][1]), bf2f(x1q[m][1] >> 16)};
#pragma unroll
            for (int e = 0; e < 4; ++e) y[4 * m + e] = DN_ALPHA * x1[e] + g2[e] * y[4 * m + e]; }
        { float sm = 0.f;
#pragma unroll
          for (int i = 0; i < 16; ++i) sm += y[i];
          const float mean = wave_sum(sm, lane) * (1.0f / 1024.0f);
          float qs = 0.f;
#pragma unroll
          for (int i = 0; i < 16; ++i) { y[i] -= mean; qs += y[i] * y[i]; }
          const float rstd = rsqrtf(wave_sum(qs, lane) * (1.0f / 1024.0f) + LN_EPS);
#pragma unroll
          for (int m = 0; m < 4; ++m) { const int col = 128 * (4 * hh + m) + 4 * r; f32x4 o_;
#pragma unroll
              for (int e = 0; e < 4; ++e) o_[e] = y[4 * m + e] * rstd * gmv[m][e] + btv[m][e];
              if (layer == 0) { *(u32x2*)(XO + (size_t)tok * D + col) = (u32x2){pk2(o_[0], o_[1]), pk2(o_[2], o_[3])};
                  const f32x4 hq = o_ * scv[m] + shv[m];
                  *(u32x2*)(c.ws<bf16_t>(WS_MIX) + (size_t)tok * D + col) = (u32x2){pk2(hq[0], hq[1]), pk2(hq[2], hq[3])}; }
              else *(f32x4*)(X + (size_t)tok * D + col) = o_; } }
        id0 = idn0; id1 = idn1; w0 = wn0; w1 = wn1; wmax = wmaxn;
    }
#undef GV_ISSUE
#undef GV_COMPUTE
#undef GV_PAIR
#undef GV_WEIGHTS
#undef GV_NORM
}

typedef unsigned cf;
struct cs { float x, y; };
__device__ __forceinline__ cs smul(cs a, cs b) { return cs{a.x * b.x - a.y * b.y, a.x * b.y + a.y * b.x}; }
__device__ __forceinline__ cs smulc(cs a, cs b) { return cs{a.x * b.x + a.y * b.y, a.y * b.x - a.x * b.y}; }
__device__ __forceinline__ cf cpack(float re, float im) { cf r; asm("v_cvt_pk_f16_f32 %0, %1, %2" : "=v"(r) : "v"(re), "v"(im)); return r; }
__device__ __forceinline__ cs cunpack(cf v) { typedef _Float16 h2 __attribute__((ext_vector_type(2))); const h2 h = __builtin_bit_cast(h2, v); return cs{(float)h[0], (float)h[1]}; }
__device__ __forceinline__ cf cmul(cf a, cf b) { cf t, r;
    asm("v_pk_mul_f16 %0, %1, %2 op_sel:[1,1] op_sel_hi:[1,0]" : "=v"(t) : "v"(a), "v"(b));
    asm("v_pk_fma_f16 %0, %1, %2, %3 op_sel:[0,0,0] op_sel_hi:[0,1,1] neg_lo:[0,0,1]" : "=v"(r) : "v"(a), "v"(b), "v"(t)); return r; }
__device__ __forceinline__ cf cmulc(cf a, cf b) { cf t, r;
    asm("v_pk_mul_f16 %0, %1, %2 op_sel:[1,1] op_sel_hi:[0,1]" : "=v"(t) : "v"(a), "v"(b));
    asm("v_pk_fma_f16 %0, %1, %2, %3 op_sel:[0,0,0] op_sel_hi:[1,0,1] neg_hi:[0,0,1]" : "=v"(r) : "v"(a), "v"(b), "v"(t)); return r; }
__device__ __forceinline__ cf cmul_k(cf a, cf b) { cf t, r;
    asm("v_pk_mul_f16 %0, %1, %2 op_sel:[1,1] op_sel_hi:[1,0]" : "=v"(t) : "v"(a), "s"(b));
    asm("v_pk_fma_f16 %0, %1, %2, %3 op_sel:[0,0,0] op_sel_hi:[0,1,1] neg_lo:[0,0,1]" : "=v"(r) : "v"(a), "s"(b), "v"(t)); return r; }
__device__ __forceinline__ cf cmulc_k(cf a, cf b) { cf t, r;
    asm("v_pk_mul_f16 %0, %1, %2 op_sel:[1,1] op_sel_hi:[0,1]" : "=v"(t) : "v"(a), "s"(b));
    asm("v_pk_fma_f16 %0, %1, %2, %3 op_sel:[0,0,0] op_sel_hi:[1,0,1] neg_hi:[0,0,1]" : "=v"(r) : "v"(a), "s"(b), "v"(t)); return r; }
__device__ __forceinline__ cf cscale(cf a, cf s2) { cf r; asm("v_pk_mul_f16 %0, %1, %2" : "=v"(r) : "v"(a), "v"(s2)); return r; }
__device__ __forceinline__ cf cadd(cf a, cf b) { cf r; asm("v_pk_add_f16 %0, %1, %2" : "=v"(r) : "v"(a), "v"(b)); return r; }
__device__ __forceinline__ cf csub(cf a, cf b) { cf r; asm("v_pk_add_f16 %0, %1, %2 neg_lo:[0,1] neg_hi:[0,1]" : "=v"(r) : "v"(a), "v"(b)); return r; }
__device__ __forceinline__ cf cadd_mi(cf a, cf b) { cf r; asm("v_pk_add_f16 %0, %1, %2 op_sel:[0,1] op_sel_hi:[1,0] neg_hi:[0,1]" : "=v"(r) : "v"(a), "v"(b)); return r; }
__device__ __forceinline__ cf cadd_pi(cf a, cf b) { cf r; asm("v_pk_add_f16 %0, %1, %2 op_sel:[0,1] op_sel_hi:[1,0] neg_lo:[0,1]" : "=v"(r) : "v"(a), "v"(b)); return r; }
template <bool INV> __device__ __forceinline__ void dft4(cf& a0, cf& a1, cf& a2, cf& a3) {
    const cf s02 = cadd(a0, a2), d02 = csub(a0, a2), s13 = cadd(a1, a3), d13 = csub(a1, a3);
    a0 = cadd(s02, s13); a2 = csub(s02, s13);
    a1 = INV ? cadd_pi(d02, d13) : cadd_mi(d02, d13); a3 = INV ? cadd_mi(d02, d13) : cadd_pi(d02, d13);
}
__device__ __forceinline__ constexpr cf cconst(float re, float im) { typedef _Float16 h2 __attribute__((ext_vector_type(2))); return __builtin_bit_cast(unsigned, (h2){(_Float16)re, (_Float16)im}); }
template <bool INV> __device__ __forceinline__ cf w16(cf a, int m) {
    const float c1 = 0.92387953251128674f, s1 = 0.38268343236508977f, r = 0.70710678118654752f;
    cf w;
    switch (m) { case 0: return a; case 1: w = cconst(c1, -s1); break; case 2: w = cconst(r, -r); break; case 3: w = cconst(s1, -c1); break; case 4: w = cconst(0.f, -1.f); break; case 6: w = cconst(-r, -r); break; default: w = cconst(-c1, s1); break; }
    return INV ? cmulc_k(a, w) : cmul_k(a, w);
}
template <bool INV> __device__ __forceinline__ void dft16(cf (&v)[16]) {
#pragma unroll
    for (int b = 0; b < 4; ++b) dft4<INV>(v[b], v[4 + b], v[8 + b], v[12 + b]);
#pragma unroll
    for (int k1 = 1; k1 < 4; ++k1)
#pragma unroll
        for (int b = 1; b < 4; ++b) v[4 * k1 + b] = w16<INV>(v[4 * k1 + b], b * k1);
#pragma unroll
    for (int k1 = 0; k1 < 4; ++k1) dft4<INV>(v[4 * k1], v[4 * k1 + 1], v[4 * k1 + 2], v[4 * k1 + 3]);
}
__device__ __forceinline__ int fpad(int p) { return p + ((p >> 6) << 2); }
typedef LAS unsigned* cbuf_t;
__device__ __forceinline__ cf ldc(cbuf_t b, int i) { return b[i]; }
__device__ __forceinline__ void stc(cbuf_t b, int i, cf v) { b[i] = v; }
__device__ __forceinline__ void wpowers(cf w, cf (&p)[16]) {
    p[1] = w; p[2] = cmul(w, w); p[3] = cmul(p[2], w); p[4] = cmul(p[2], p[2]); p[5] = cmul(p[4], w); p[6] = cmul(p[3], p[3]); p[7] = cmul(p[4], p[3]);
    p[8] = cmul(p[4], p[4]); p[9] = cmul(p[8], w); p[10] = cmul(p[5], p[5]); p[11] = cmul(p[8], p[3]); p[12] = cmul(p[6], p[6]); p[13] = cmul(p[8], p[5]); p[14] = cmul(p[7], p[7]); p[15] = cmul(p[8], p[7]);
}
template <bool INV, int PS> __device__ __forceinline__ void fft_stage16(cbuf_t buf, int pb, cf w) {
    cf v[16], p[16];
#pragma unroll
    for (int j = 0; j < 16; ++j) v[j] = ldc(buf, pb + j * PS);
    wpowers(w, p);
    if (INV) {
#pragma unroll
        for (int k = 1; k < 16; ++k) v[k] = cmulc(v[k], p[k]);
    }
    dft16<INV>(v);
    if (!INV) {
#pragma unroll
        for (int k = 1; k < 16; ++k) { const int r = 4 * (k & 3) + (k >> 2); v[r] = cmul(v[r], p[k]); }
    }
#pragma unroll
    for (int k = 0; k < 16; ++k) stc(buf, pb + k * PS, v[4 * (k & 3) + (k >> 2)]);
}
__device__ __forceinline__ cf ldtw(const f32x2* t, int i) { const f32x2 v = t[i]; return cpack(v[0], v[1]); }

__device__ __forceinline__ void fft_fwd_to_regs(cbuf_t buf, int tid, const f32x2* tws, unsigned (&K)[32], float sc) {
#pragma unroll
    for (int rep = 0; rep < 2; ++rep) { const int id = tid + NT * rep; fft_stage16<false, 1088>(buf, fpad(id), ldtw(tws, id)); }
    __syncthreads();
#pragma unroll
    for (int rep = 0; rep < 2; ++rep) { const int id = tid + NT * rep; fft_stage16<false, 68>(buf, fpad((id >> 6) * 1024 + (id & 63)), ldtw(tws + 1024, id & 63)); }
    __syncthreads();
#pragma unroll
    for (int rep = 0; rep < 2; ++rep) { const int id = tid + NT * rep; fft_stage16<false, 4>(buf, fpad((id >> 2) * 64 + (id & 3)), ldtw(tws + 1088, id & 3)); }
    __syncthreads();
    const cf scv = cpack(sc, sc);
#pragma unroll
    for (int rep = 0; rep < 8; ++rep) { const int base = fpad(4 * (tid + NT * rep));
        cf a0 = ldc(buf, base), a1 = ldc(buf, base + 1), a2 = ldc(buf, base + 2), a3 = ldc(buf, base + 3);
        dft4<false>(a0, a1, a2, a3);
        K[4 * rep] = cscale(a0, scv); K[4 * rep + 1] = cscale(a1, scv); K[4 * rep + 2] = cscale(a2, scv); K[4 * rep + 3] = cscale(a3, scv); }
    __syncthreads();
}
__device__ __forceinline__ void fft_conv_with_regs(cbuf_t buf, int tid, const f32x2* tws, const unsigned (&K)[32]) {
#pragma unroll
    for (int rep = 0; rep < 2; ++rep) { const int id = tid + NT * rep; fft_stage16<false, 1088>(buf, fpad(id), ldtw(tws, id)); }
    __syncthreads();
#pragma unroll
    for (int rep = 0; rep < 2; ++rep) { const int id = tid + NT * rep; fft_stage16<false, 68>(buf, fpad((id >> 6) * 1024 + (id & 63)), ldtw(tws + 1024, id & 63)); }
    __syncthreads();
#pragma unroll
    for (int rep = 0; rep < 2; ++rep) { const int id = tid + NT * rep; fft_stage16<false, 4>(buf, fpad((id >> 2) * 64 + (id & 3)), ldtw(tws + 1088, id & 3)); }
    __syncthreads();
#pragma unroll
    for (int rep = 0; rep < 8; ++rep) { const int base = fpad(4 * (tid + NT * rep));
        cf a0 = ldc(buf, base), a1 = ldc(buf, base + 1), a2 = ldc(buf, base + 2), a3 = ldc(buf, base + 3);
        dft4<false>(a0, a1, a2, a3);
        a0 = cmul(a0, K[4 * rep]); a1 = cmul(a1, K[4 * rep + 1]); a2 = cmul(a2, K[4 * rep + 2]); a3 = cmul(a3, K[4 * rep + 3]);
        dft4<true>(a0, a1, a2, a3);
        stc(buf, base, a0); stc(buf, base + 1, a1); stc(buf, base + 2, a2); stc(buf, base + 3, a3); }
    __syncthreads();
#pragma unroll
    for (int rep = 0; rep < 2; ++rep) { const int id = tid + NT * rep; fft_stage16<true, 4>(buf, fpad((id >> 2) * 64 + (id & 3)), ldtw(tws + 1088, id & 3)); }
    __syncthreads();
#pragma unroll
    for (int rep = 0; rep < 2; ++rep) { const int id = tid + NT * rep; fft_stage16<true, 68>(buf, fpad((id >> 6) * 1024 + (id & 63)), ldtw(tws + 1024, id & 63)); }
    __syncthreads();
#pragma unroll
    for (int rep = 0; rep < 2; ++rep) { const int id = tid + NT * rep; fft_stage16<true, 1088>(buf, fpad(id), ldtw(tws, id)); }
    __syncthreads();
}

__device__ __forceinline__ void sconv8(const bf16_t* row, int t0, float w0, float w1, float w2, float cb, float (&o)[8]) {
    const u32x4 m = *(const u32x4*)(row + t0);
    const unsigned lraw = *(const unsigned*)(row + (t0 > 0 ? t0 - 2 : 0));
    const unsigned rraw = *(const unsigned*)(row + (t0 + 8 < SEQ ? t0 + 8 : SEQ - 2));
    const unsigned l = t0 > 0 ? lraw : 0u, r = t0 + 8 < SEQ ? rraw : 0u;
    float x[10];
    x[0] = bf2f(l >> 16); x[9] = bf2f(r);
#pragma unroll
    for (int k = 0; k < 4; ++k) { x[1 + 2 * k] = bf2f(m[k]); x[2 + 2 * k] = bf2f(m[k] >> 16); }
#pragma unroll
    for (int k = 0; k < 8; ++k) o[k] = w0 * x[k] + w1 * x[k + 1] + w2 * x[k + 2] + cb;
}
__device__ __forceinline__ void unpack8(const u32x4 m, float (&x)[8]) {
#pragma unroll
    for (int k = 0; k < 4; ++k) { x[2 * k] = bf2f(m[k]); x[2 * k + 1] = bf2f(m[k] >> 16); }
}
__device__ void phase_hyena_conv(const Ctx& c) {
    cbuf_t buf = (cbuf_t)c.lds;
    LAS float* red = (LAS float*)(c.lds + 139264);
    const bf16_t* ZT = c.ws<bf16_t>(WS_BIG);
    bf16_t* YT = c.ws<bf16_t>(WS_MIX);
    const bf16_t* FILT = c.ws<bf16_t>(WS_FILT);
    const f32x2* tws = c.ws<f32x2>(WS_TWS);
    const f32x2* twodd = c.ws<f32x2>(WS_TWODD);
    unsigned* scr_vv = c.ws<unsigned>(WS_HB) + (size_t)c.bid * 2 * SEQ;
    unsigned* scr_re = scr_vv + SEQ;
    const float* CW = c.in(I_HYCW); const float* CB = c.in(I_HYCB);
    const int tid = c.tid;
    const int rot = c.bid & 3;
    constexpr float FS = 1.0f / 16.0f, ZS = 1.0f / 256.0f;
    LAS unsigned* twl = (LAS unsigned*)(c.lds + 69632);
    __syncthreads();
    for (int e = tid; e < SEQ; e += NT) { const f32x2 w = twodd[e]; twl[e] = cpack(w[0], w[1]); }
#define TWL8(t0, wa, wb) const u32x4 wa = *(const LAS u32x4*)(twl + (t0)), wb = *(const LAS u32x4*)(twl + (t0) + 4)
#define TWJ(wa, wb, j) cunpack((j) < 4 ? wa[(j) & 3] : wb[(j) & 3])
#define T8(m) (8 * (tid + NT * (((m) + rot) & 3)))
#define LDSQ(t0, k) (*(LAS u32x2*)(buf + fpad((t0) + 2 * (k))))
    for (int ch = c.bid; ch < 1024; ch += c.G) {
        const bf16_t* fw = FILT + (size_t)ch * SEQ; const bf16_t* bw = FILT + (size_t)(1024 + ch) * SEQ;
        unsigned K[32];
        __syncthreads();
        float l1p = 0.f;
#pragma unroll
        for (int m = 0; m < 4; ++m) { const int t0 = T8(m); float f[8], b[8]; unpack8(*(const u32x4*)(fw + t0), f); unpack8(*(const u32x4*)(bw + t0), b);
#pragma unroll
            for (int k = 0; k < 4; ++k) { l1p += (fabsf(f[2 * k]) + fabsf(b[2 * k])) + (fabsf(f[2 * k + 1]) + fabsf(b[2 * k + 1])); LDSQ(t0, k) = (u32x2){cpack((f[2 * k] + b[2 * k]) * FS, 0.f), cpack((f[2 * k + 1] + b[2 * k + 1]) * FS, 0.f)}; } }
        l1p = wave_sum(l1p, c.lane);
        if (c.lane == 0) red[c.wave] = l1p;
        __syncthreads();
        float l1 = 0.f;
#pragma unroll
        for (int w = 0; w < 8; ++w) l1 += red[w];
        const float il1 = 1.0f / l1, ksc = il1 * (1.0f / FS);
        fft_fwd_to_regs(buf, tid, tws, K, ksc);
        {
            const float wx0 = CW[0 * HY3 + 1024 + ch], wx1 = CW[1 * HY3 + 1024 + ch], wx2 = CW[2 * HY3 + 1024 + ch], cbx = CB[1024 + ch];
            const float wv0 = CW[0 * HY3 + 2048 + ch], wv1 = CW[1 * HY3 + 2048 + ch], wv2 = CW[2 * HY3 + 2048 + ch], cbv = CB[2048 + ch];
            const bf16_t* x1r = ZT + (size_t)(1024 + ch) * NTOK; const bf16_t* vr = ZT + (size_t)(2048 + ch) * NTOK;
#pragma unroll 2
            for (int m = 0; m < 4; ++m) { const int t0 = T8(m);
                float va[8], xa[8], vb[8], xb[8];
                sconv8(vr, t0, wv0, wv1, wv2, cbv, va); sconv8(x1r, t0, wx0, wx1, wx2, cbx, xa);
                sconv8(vr + SEQ, t0, wv0, wv1, wv2, cbv, vb); sconv8(x1r + SEQ, t0, wx0, wx1, wx2, cbx, xb);
                u32x4 pv[2];
#pragma unroll
                for (int k = 0; k < 4; ++k) { const f32x4 z = (f32x4){va[2 * k] * xa[2 * k], vb[2 * k] * xb[2 * k], va[2 * k + 1] * xa[2 * k + 1], vb[2 * k + 1] * xb[2 * k + 1]};
                    pv[k >> 1][2 * (k & 1)] = pk2(z[0], z[1]); pv[k >> 1][2 * (k & 1) + 1] = pk2(z[2], z[3]); LDSQ(t0, k) = (u32x2){cpack(z[0] * ZS, z[1] * ZS), cpack(z[2] * ZS, z[3] * ZS)}; }
                *(u32x4*)(scr_vv + t0) = pv[0]; *(u32x4*)(scr_vv + t0 + 4) = pv[1]; }
        }
        __syncthreads();
        fft_conv_with_regs(buf, tid, tws, K);
#pragma unroll 2
        for (int m = 0; m < 4; ++m) { const int t0 = T8(m); float f[8], b[8]; unpack8(*(const u32x4*)(fw + t0), f); unpack8(*(const u32x4*)(bw + t0), b);
            u32x4 pr[2]; TWL8(t0, twa, twb);
#pragma unroll
            for (int k = 0; k < 4; ++k) { const cs w0_ = TWJ(twa, twb, 2 * k), w1_ = TWJ(twa, twb, 2 * k + 1); const f32x4 w = (f32x4){w0_.x, w0_.y, w1_.x, w1_.y};
                { const u32x2 rq = LDSQ(t0, k); const cs r0 = cunpack(rq[0]), r1 = cunpack(rq[1]); pr[k >> 1][2 * (k & 1)] = pk2(r0.x, r0.y); pr[k >> 1][2 * (k & 1) + 1] = pk2(r1.x, r1.y); }
                const float d0 = (f[2 * k] - b[2 * k]) * FS, d1 = (f[2 * k + 1] - b[2 * k + 1]) * FS;
                LDSQ(t0, k) = (u32x2){cpack(d0 * w[0], d0 * w[1]), cpack(d1 * w[2], d1 * w[3])}; }
            *(u32x4*)(scr_re + t0) = pr[0]; *(u32x4*)(scr_re + t0 + 4) = pr[1]; }
        __syncthreads();
        fft_fwd_to_regs(buf, tid, tws, K, ksc);
#pragma unroll 2
        for (int m = 0; m < 4; ++m) { const int t0 = T8(m);
            const u32x4 pv0 = *(const u32x4*)(scr_vv + t0), pv1 = *(const u32x4*)(scr_vv + t0 + 4); TWL8(t0, twa, twb);
#pragma unroll
            for (int k = 0; k < 4; ++k) { const unsigned u0 = k < 2 ? pv0[2 * k] : pv1[2 * k - 4], u1 = k < 2 ? pv0[2 * k + 1] : pv1[2 * k - 3]; const cs w0_ = TWJ(twa, twb, 2 * k), w1_ = TWJ(twa, twb, 2 * k + 1); const f32x4 w = (f32x4){w0_.x, w0_.y, w1_.x, w1_.y};
                const cs a = smul(cs{bf2f(u0) * ZS, bf2f(u0 >> 16) * ZS}, cs{w[0], w[1]}), b = smul(cs{bf2f(u1) * ZS, bf2f(u1 >> 16) * ZS}, cs{w[2], w[3]}); LDSQ(t0, k) = (u32x2){cpack(a.x, a.y), cpack(b.x, b.y)}; } }
        __syncthreads();
        fft_conv_with_regs(buf, tid, tws, K);
        {
            const float w00 = CW[0 * HY3 + ch], w01 = CW[1 * HY3 + ch], w02 = CW[2 * HY3 + ch], cb0 = CB[ch];
            const bf16_t* x0r = ZT + (size_t)ch * NTOK;
            const float dsk = c.in(I_HYD)[ch], scale = 0.5f / 16384.0f / ZS;
#pragma unroll 2
            for (int m = 0; m < 4; ++m) { const int t0 = T8(m);
                float xa[8], xb[8]; sconv8(x0r, t0, w00, w01, w02, cb0, xa); sconv8(x0r + SEQ, t0, w00, w01, w02, cb0, xb);
                u32x4 oa, ob;
                const u32x4 pr0 = *(const u32x4*)(scr_re + t0), pr1 = *(const u32x4*)(scr_re + t0 + 4), pv0 = *(const u32x4*)(scr_vv + t0), pv1 = *(const u32x4*)(scr_vv + t0 + 4); TWL8(t0, twa, twb);
#pragma unroll
                for (int k = 0; k < 4; ++k) { const u32x2 rq = LDSQ(t0, k); const cs ro0 = cunpack(rq[0]), ro1 = cunpack(rq[1]); const cs w0_ = TWJ(twa, twb, 2 * k), w1_ = TWJ(twa, twb, 2 * k + 1); const f32x4 w = (f32x4){w0_.x, w0_.y, w1_.x, w1_.y};
                    const unsigned r0 = k < 2 ? pr0[2 * k] : pr1[2 * k - 4], r1 = k < 2 ? pr0[2 * k + 1] : pr1[2 * k - 3], v0 = k < 2 ? pv0[2 * k] : pv1[2 * k - 4], v1 = k < 2 ? pv0[2 * k + 1] : pv1[2 * k - 3];
                    const f32x4 re = (f32x4){bf2f(r0), bf2f(r0 >> 16), bf2f(r1), bf2f(r1 >> 16)}, vv = (f32x4){bf2f(v0), bf2f(v0 >> 16), bf2f(v1), bf2f(v1 >> 16)};
                    const cs q0 = smulc(ro0, cs{w[0], w[1]}), q1 = smulc(ro1, cs{w[2], w[3]});
                    const float ya0 = ((re[0] + q0.x) * scale + vv[0] * dsk) * xa[2 * k], yb0 = ((re[1] + q0.y) * scale + vv[1] * dsk) * xb[2 * k];
                    const float ya1 = ((re[2] + q1.x) * scale + vv[2] * dsk) * xa[2 * k + 1], yb1 = ((re[3] + q1.y) * scale + vv[3] * dsk) * xb[2 * k + 1];
                    oa[k] = pk2(ya0, ya1); ob[k] = pk2(yb0, yb1); }
                *(u32x4*)(YT + (size_t)ch * NTOK + t0) = oa; *(u32x4*)(YT + (size_t)ch * NTOK + SEQ + t0) = ob; }
        }
    }
#undef LDSQ
#undef T8
#undef TWL8
#undef TWJ
    __syncthreads();
}

__device__ void phase_transpose_y(const Ctx& c) {
    const bf16_t* YT = c.ws<bf16_t>(WS_MIX); bf16_t* Y = c.ws<bf16_t>(WS_HB);
    LAS bf16_t* t = (LAS bf16_t*)c.lds;
    for (int tile0 = c.bid * 4; tile0 < 16 * 512; tile0 += c.G * 4) {
        __syncthreads();
        u32x4 v[4];
        { const int r = c.tid >> 3, q = c.tid & 7;
#pragma unroll
          for (int u = 0; u < 4; ++u) { const int tile = tile0 + u, c0 = (tile & 15) * 64, n0 = (tile >> 4) * 64; v[u] = *(const u32x4*)(YT + (size_t)(c0 + r) * NTOK + n0 + q * 8); }
#pragma unroll
          for (int u = 0; u < 4; ++u) { const unsigned w[4] = {v[u].x, v[u].y, v[u].z, v[u].w};
#pragma unroll
              for (int e = 0; e < 8; ++e) t[u * 64 * 72 + (q * 8 + e) * 72 + r] = (bf16_t)((w[e >> 1] >> (16 * (e & 1))) & 0xffffu); } }
        __syncthreads();
        { const int n = c.tid >> 3, q = c.tid & 7;
#pragma unroll
          for (int u = 0; u < 4; ++u) { const int tile = tile0 + u, c0 = (tile & 15) * 64, n0 = (tile >> 4) * 64; *(u32x4*)(Y + (size_t)(n0 + n) * D + c0 + q * 8) = *(const LAS u32x4*)(t + u * 64 * 72 + n * 72 + q * 8); } }
    }
    __syncthreads();
}

#define XB_TMO      128
#define XB_XCNT(j)  (256  + 64 * (j))
#define XB_XSUB(j)  (1280 + 64 * (j))
#define XB_XGEN(j)  (2304 + 64 * (j))
#define XB_TOP      3328
#define XB_TOPGEN   3392
#define XCD_BAR_WORDS 3456
#define XB_SPIN_CAP (1u << 18)
__device__ __forceinline__ unsigned xb_ld(unsigned* p)              { return __hip_atomic_load(p, __ATOMIC_RELAXED, __HIP_MEMORY_SCOPE_AGENT); }
__device__ __forceinline__ unsigned xb_add(unsigned* p, unsigned v) { return __hip_atomic_fetch_add(p, v, __ATOMIC_RELAXED, __HIP_MEMORY_SCOPE_AGENT); }
__device__ __forceinline__ unsigned xb_xcc_id() { return (unsigned)__builtin_amdgcn_s_getreg((3 << 11) | 20) & 0xFu; }
#define XB_SPIN(cond, bar) do { unsigned _sp = 0; while (cond) { __builtin_amdgcn_s_sleep(1); \
    if ((++_sp & 255u) == 0u) { if (xb_ld(&(bar)[XB_TMO])) break; if (_sp > XB_SPIN_CAP) { atomicAdd(&(bar)[XB_TMO], 1u); break; } } } } while (0)
struct XcdBarrier { unsigned* bar; unsigned x; volatile LAS unsigned* st; };
__device__ __forceinline__ XcdBarrier xcd_barrier_post(unsigned* bar, volatile LAS unsigned* st, int tid) {
    XcdBarrier b; b.bar = bar; b.x = xb_xcc_id(); b.st = st;
    if (tid == 0) (void)xb_add(&bar[XB_XCNT(b.x)], 1u);
    return b;
}
__device__ __forceinline__ void xcd_barrier_complete(unsigned* bar, unsigned x, unsigned& nloc, unsigned& nx) {
    const unsigned G = gridDim.x * gridDim.y * gridDim.z;
    unsigned sum, cnt, mine, sp = 0u;
    for (;;) {
        sum = 0u; cnt = 0u; mine = 0u;
#pragma unroll
        for (unsigned j = 0; j < 16; ++j) { const unsigned c = xb_ld(&bar[XB_XCNT(j)]); sum += c; cnt += (c > 0u) ? 1u : 0u; mine = (j == x) ? c : mine; }
        if (sum == G) break;
        __builtin_amdgcn_s_sleep(1);
        if ((++sp & 255u) == 0u) { if (xb_ld(&bar[XB_TMO])) break; if (sp > XB_SPIN_CAP) { atomicAdd(&bar[XB_TMO], 1u); break; } }
    }
    nloc = mine > 0u ? mine : 1u; nx = cnt > 0u ? cnt : 1u;
}
__device__ __forceinline__ void xcd_barrier(const XcdBarrier& b, int tid) {
    asm volatile("s_waitcnt vmcnt(0)" ::: "memory");
    __syncthreads();
    if (tid == 0) {
        unsigned* bar = b.bar;
        __builtin_amdgcn_s_waitcnt(0);
        unsigned nloc = b.st[0], nx = b.st[1];
        if (nloc == 0u) { xcd_barrier_complete(bar, b.x, nloc, nx); b.st[0] = nloc; b.st[1] = nx; }
        const unsigned old = xb_add(&bar[XB_XSUB(b.x)], 1u);
        const unsigned gen = old / nloc;
        if (old + 1u == (gen + 1u) * nloc) {
            __builtin_amdgcn_fence(__ATOMIC_RELEASE, "agent");
            asm volatile("s_waitcnt vmcnt(0)" ::: "memory");
            const unsigned og = xb_add(&bar[XB_TOP], 1u);
            const unsigned tg = og / nx;
            if (og + 1u == (tg + 1u) * nx) xb_add(&bar[XB_TOPGEN], 1u);
            else XB_SPIN(xb_ld(&bar[XB_TOPGEN]) == tg, bar);
            __builtin_amdgcn_fence(__ATOMIC_ACQUIRE, "agent");
            xb_add(&bar[XB_XGEN(b.x)], 1u);
            asm volatile("s_waitcnt vmcnt(0)" ::: "memory");
        } else {
            XB_SPIN(xb_ld(&bar[XB_XGEN(b.x)]) == gen, bar);
            __builtin_amdgcn_fence(__ATOMIC_ACQUIRE, "agent");
            asm volatile("s_waitcnt vmcnt(0)" ::: "memory");
        }
    }
    __syncthreads();
}

constexpr int NPH = 19;
template <int P> __device__ __forceinline__ void run_phase(const Ctx& c) {
    const Args& args = *c.a;
    if constexpr (P == 0) phase_prep(c);
    if constexpr (P == 1) phase_mod0_filt(c);
    if constexpr (P == 2) {
        { pg8::Gemm g{c.ws<bf16_t>(WS_HB), c.ws<bf16_t>(WS_WIN_T), NTOK, ABIN, D}; pg8::StaticOrder S; S.init(NTOK, ABIN, c.G, c.bid, 4);
          pg8::EpiBf16 E{c.ws<bf16_t>(WS_BIG), ABIN, 6, nullptr}; pg8::gemm_phase<decltype(E), pg8::StaticOrder, true, true>(c.lds, g, S, E, c.tid); }
        { pg8::Gemm g{c.ws<bf16_t>(WS_HCTX), c.ws<bf16_t>(WS_WIN_T) + (size_t)512 * D, NCTX, 1024, D}; pg8::StaticOrder S; S.init(NCTX, 1024, c.G, c.bid);
          pg8::EpiBf16 E{c.ws<bf16_t>(WS_KVC), 1024, 1 << 30, nullptr}; pg8::gemm_phase<decltype(E), pg8::StaticOrder, true, true>(c.lds, g, S, E, c.tid); }
    }
    if constexpr (P == 3) { phase_attn(c); phase_gating(c); }
    if constexpr (P == 4) { pg8::Gemm g{c.ws<bf16_t>(WS_MIX), c.ws<bf16_t>(WS_WOUT_T), NTOK, D, D}; pg8::StaticOrder S; S.init(NTOK, D, c.G, c.bid);
        pg8::EpiBf16 E{c.ws<bf16_t>(WS_BIG), D, 1 << 30, nullptr}; pg8::gemm_phase<decltype(E), pg8::StaticOrder, true, true>(c.lds, g, S, E, c.tid); }
    if constexpr (P == 5) phase_ln1(c, 0);
    if constexpr (P == 6) { pg8::Gemm g{c.ws<bf16_t>(WS_HB), c.ws<bf16_t>(WS_WK_T), NTOK, PQN, D}; pg8::StaticOrder S; S.init(NTOK, PQN, c.G, c.bid, 4);
        pg8::EpiF16 E{c.ws<_Float16>(WS_BIG), PQN}; pg8::gemm_phase<decltype(E), pg8::StaticOrder, true, true>(c.lds, g, S, E, c.tid); }
    if constexpr (P == 7) phase_topk(c);
    if constexpr (P == 8) phase_gather_u(c, 0);
    if constexpr (P == 9) phase_gather_v(c, 0);
    if constexpr (P == 10) {
        pg8::Gemm g{c.ws<bf16_t>(WS_HYIN_T), c.ws<bf16_t>(WS_MIX), HY3, NTOK, D}; pg8::StaticOrder S; S.init(HY3, NTOK, c.G, c.bid);
        pg8::EpiBf16 E{c.ws<bf16_t>(WS_BIG), NTOK, 1 << 30, c.in(I_HYBIN)}; pg8::gemm_phase<decltype(E), pg8::StaticOrder, true, true>(c.lds, g, S, E, c.tid); }
    if constexpr (P == 11) phase_hyena_conv(c);
    if constexpr (P == 12) phase_transpose_y(c);
    if constexpr (P == 13) { pg8::Gemm g{c.ws<bf16_t>(WS_HB), c.ws<bf16_t>(WS_HYOUT_T), NTOK, D, D}; pg8::StaticOrder S; S.init(NTOK, D, c.G, c.bid);
        pg8::EpiBf16 E{c.ws<bf16_t>(WS_BIG), D, 1 << 30, nullptr}; pg8::gemm_phase<decltype(E), pg8::StaticOrder, true, true>(c.lds, g, S, E, c.tid); }
    if constexpr (P == 14) phase_ln1(c, 1);
    if constexpr (P == 15) { pg8::Gemm g{c.ws<bf16_t>(WS_HB), c.ws<bf16_t>(WS_WK_T) + (size_t)PQN * D, NTOK, PQN, D}; pg8::StaticOrder S; S.init(NTOK, PQN, c.G, c.bid, 4);
        pg8::EpiF16 E{c.ws<_Float16>(WS_BIG), PQN}; pg8::gemm_phase<decltype(E), pg8::StaticOrder, true, true>(c.lds, g, S, E, c.tid); }
    if constexpr (P == 16) phase_topk(c);
    if constexpr (P == 17) phase_gather_u(c, 1);
    if constexpr (P == 18) phase_gather_v(c, 1);
}
__device__ __forceinline__ int phase_tid(int wave0) {
    int t = wave0 * 64 + (int)__builtin_amdgcn_mbcnt_hi(~0u, __builtin_amdgcn_mbcnt_lo(~0u, 0u)); asm volatile("" : "+v"(t)); return t;
}
__device__ __forceinline__ Ctx make_ctx(const Args* a, unsigned char* lds_raw, int wave0) {
    int t = phase_tid(wave0);
    Ctx c; c.a = a; c.lds = (LAS unsigned char*)lds_raw; c.tid = t; c.lane = c.tid & 63; c.wave = __builtin_amdgcn_readfirstlane(c.tid >> 6); c.G = gridDim.x; c.bid = blockIdx.x; return c;
}
template <int P>
__global__ void __launch_bounds__(NT) phase_kernel(Args args) {
    __shared__ __attribute__((aligned(16))) unsigned char lds_raw[LDS_BYTES];
    const Ctx c = make_ctx(&args, lds_raw, __builtin_amdgcn_readfirstlane((int)threadIdx.x >> 6));
    run_phase<P>(c);
}
#if ONE_LAUNCH
__device__ __forceinline__ XcdBarrier make_xb(const Args* a, unsigned char* lds_raw) { XcdBarrier b; b.bar = (unsigned*)(a->ws + WS_BAR); b.x = xb_xcc_id(); b.st = (volatile LAS unsigned*)((LAS unsigned char*)lds_raw + LDS_BYTES - 16); return b; }
template <int P> __device__ __forceinline__ void run_all(const Args* a, unsigned char* lds_raw, int wave0) {
#ifndef DBG_LO
#define DBG_LO 0
#define DBG_HI NPH
#endif
    if constexpr (P < NPH) {
        if constexpr (P >= DBG_LO && P < DBG_HI) { const Ctx c = make_ctx(a, lds_raw, wave0); run_phase<P>(c); }
        if constexpr (((DUP_MASK >> P) & 1) != 0) { xcd_barrier(make_xb(a, lds_raw), phase_tid(wave0)); const Ctx c2 = make_ctx(a, lds_raw, wave0); run_phase<P>(c2); }
        if constexpr (P + 1 < NPH) { xcd_barrier(make_xb(a, lds_raw), phase_tid(wave0)); run_all<P + 1>(a, lds_raw, wave0); }
    }
}
__global__ void __launch_bounds__(NT) mega(Args args) {
    __shared__ __attribute__((aligned(16))) unsigned char lds_raw[LDS_BYTES];
    volatile LAS unsigned* st = (volatile LAS unsigned*)((LAS unsigned char*)lds_raw + LDS_BYTES - 16);
    const int wave0 = __builtin_amdgcn_readfirstlane((int)threadIdx.x >> 6);
    const int tid0 = phase_tid(wave0);
    if (tid0 == 0) { st[0] = 0u; st[1] = 0u; }
    __syncthreads();
    (void)xcd_barrier_post((unsigned*)(args.ws + WS_BAR), st, tid0);
    run_all<0>(&args, lds_raw, wave0);
}
#endif
template <int P> static void launch_phases(const Args& a, int grid, hipStream_t stream) {
    if constexpr (P < NPH) { hipLaunchKernelGGL(phase_kernel<P>, dim3(grid), dim3(NT), 0, stream, a); launch_phases<P + 1>(a, grid, stream); }
}

extern "C" void kernel_launch(void* const* d_in, const int* in_sizes, int n_in, void* d_out, int out_size, void* d_ws, size_t ws_size, hipStream_t stream) {
    static int grid = 0;
    if (grid == 0) {
        if (n_in != 30 || out_size != NTOK * D || ws_size < WS_END) { fprintf(stderr, "kernel_launch: unexpected shapes (n_in %d out %d ws %zu)\n", n_in, out_size, ws_size); grid = -1; return; }
        int dev = 0, cus = 0, per_cu = 0;
        (void)hipGetDevice(&dev); (void)hipDeviceGetAttribute(&cus, hipDeviceAttributeMultiprocessorCount, dev);
#if ONE_LAUNCH
        (void)hipOccupancyMaxActiveBlocksPerMultiprocessor(&per_cu, (const void*)mega, NT, 0);
#else
        (void)hipOccupancyMaxActiveBlocksPerMultiprocessor(&per_cu, (const void*)phase_kernel<2>, NT, 0);
#endif
        if (per_cu < 1) { fprintf(stderr, "kernel_launch: occupancy query says %d blocks per CU\n", per_cu); grid = -1; return; }
        grid = cus < 256 ? cus : 256;
        grid &= ~7;
    }
    if (grid < 0) return;
    Args a{};
    for (int i = 0; i < 30; ++i) a.in[i] = (const float*)d_in[i];
    a.out = (float*)d_out; a.ws = (unsigned char*)d_ws;
#if ONE_LAUNCH
    {
        a.ph_lo = 0; a.ph_hi = NPH;
        (void)hipMemsetAsync((char*)d_ws + WS_BAR, 0, XCD_BAR_WORDS * sizeof(unsigned), stream);
        void* kargs[] = {&a};
        hipError_t e = hipLaunchCooperativeKernel((const void*)mega, dim3(grid), dim3(NT), kargs, 0, stream);
        if (e != hipSuccess) fprintf(stderr, "cooperative launch failed: %s (grid %d)\n", hipGetErrorString(e), grid);
    }
#else
    a.ph_lo = 0; a.ph_hi = NPH; launch_phases<0>(a, grid, stream);
#endif
}
```
